# Optimizing an MI355X kernel written in HIP

```python
import math
import jax, jax.numpy as jnp
from jax import lax
import numpy as np

D_MODEL = 2048
BATCH = 2
SEQ = 8192
DEPTH = 1

ATT_HEADS = 8
ATT_HEAD_DIM = 64
ATT_V_DIM = 2 * ATT_HEAD_DIM
ATT_QK_WIDTH = ATT_HEADS * 2 * ATT_HEAD_DIM
ATT_WIDTH = ATT_HEADS * ATT_V_DIM
ROPE_DIM = ATT_HEAD_DIM // 4
ROPE_THETA = 500000.0
Q_BLOCK = 128

HY_WIDTH = 1024
HY_ORDER = 2
HY_SHORT_CONV = 3
HY_EMB_BANDS = 16
HY_EMB_DIM = 1 + 2 * HY_EMB_BANDS
HY_FILTER_HIDDEN = 64
HY_DECAY_TARGET = 1e-2
HY_FAST_DECAY_PCT = 0.3
HY_SLOW_DECAY_PCT = 1.5
HY_MIN_DECAY = math.log(HY_DECAY_TARGET) / HY_FAST_DECAY_PCT
HY_MAX_DECAY = math.log(HY_DECAY_TARGET) / HY_SLOW_DECAY_PCT

N_BRANCHES = 2
W_IN_COLS = (HY_ORDER + 1) * HY_WIDTH + 2 * ATT_QK_WIDTH + ATT_WIDTH + N_BRANCHES * D_MODEL

FFN_HIDDEN = (((8 * D_MODEL + 2) // 3 + 255) // 256) * 256

N_MOD = 6
EPS = 1e-6

kernel_name = "hybrid_hyena_diffattn_encoder_block"


def rmsnorm(x, g):
    xf = x.astype(jnp.float32)
    y = xf * lax.rsqrt(jnp.mean(xf * xf, axis=-1, keepdims=True) + EPS)
    return (y * g).astype(x.dtype)


def short_conv_centred(u, w, b):
    L = u.shape[1]
    pad = HY_SHORT_CONV // 2
    up = jnp.pad(u, ((0, 0), (pad, pad), (0, 0)))
    out = up[:, 0:L] * w[0]
    for i in range(1, HY_SHORT_CONV):
        out = out + up[:, i:i + L] * w[i]
    return out + b


def hyena_filters(L, w1, b1, w2, b2, w3, b3, freq, w_out):
    t = jnp.linspace(0.0, 1.0, L, dtype=jnp.float32)[:, None]
    w = (2.0 * math.pi / L) * jnp.arange(L, dtype=jnp.float32)[:, None]
    bands = jnp.linspace(1e-4, HY_EMB_BANDS - 1, HY_EMB_BANDS, dtype=jnp.float32)
    z = jnp.concatenate([t, jnp.cos(bands * w), -jnp.sin(bands * w)], axis=-1)
    h = jnp.sin(freq[0] * (z @ w1 + b1))
    h = jnp.sin(freq[1] * (h @ w2 + b2))
    h = jnp.sin(freq[2] * (h @ w3 + b3))
    h = (h @ w_out).reshape(L, HY_ORDER, 2, HY_WIDTH)
    deltas = jnp.abs(jnp.linspace(HY_MIN_DECAY, HY_MAX_DECAY, HY_WIDTH, dtype=jnp.float32))
    decay = jnp.exp(-t * deltas)
    return h * decay[:, None, None, :]


def bidir_long_conv(u, h_fwd, h_bwd, bias):
    L, C = h_fwd.shape
    k = jnp.concatenate([h_fwd, jnp.zeros((1, C), h_fwd.dtype), h_bwd[1:][::-1]], axis=0)
    uf = jnp.fft.rfft(u.astype(jnp.float32), n=2 * L, axis=1)
    kf = jnp.fft.rfft(k.astype(jnp.float32), n=2 * L, axis=0)
    y = jnp.fft.irfft(uf * kf[None], n=2 * L, axis=1)[:, :L]
    return (y + u * bias).astype(u.dtype)


def partial_rope(x, pos):
    half = ROPE_DIM // 2
    inv = ROPE_THETA ** (-jnp.arange(half, dtype=jnp.float32) * (2.0 / ROPE_DIM))
    ang = pos.astype(jnp.float32)[:, :, None] * inv
    cos = jnp.cos(ang)[:, :, None, None, :]
    sin = jnp.sin(ang)[:, :, None, None, :]
    xr = x[..., :ROPE_DIM].astype(jnp.float32)
    x1, x2 = xr[..., :half], xr[..., half:]
    rot = jnp.concatenate([x1 * cos - x2 * sin, x2 * cos + x1 * sin], axis=-1)
    return jnp.concatenate([rot.astype(x.dtype), x[..., ROPE_DIM:]], axis=-1)


def diff_attention(q, k, v, pos, q_g, k_g, lam, subln_g, lam_init):
    B, L = q.shape[0], q.shape[1]
    q = partial_rope(rmsnorm(q, q_g), pos) * (ATT_HEAD_DIM ** -0.5)
    k = partial_rope(rmsnorm(k, k_g), pos)
    qh = q.reshape(B, L, 2 * ATT_HEADS, ATT_HEAD_DIM).transpose(0, 2, 1, 3)
    kh = k.reshape(B, L, 2 * ATT_HEADS, ATT_HEAD_DIM).transpose(0, 2, 1, 3)
    vh = v.transpose(0, 2, 1, 3)
    nb = L // Q_BLOCK
    qb = qh.reshape(B, 2 * ATT_HEADS, nb, Q_BLOCK, ATT_HEAD_DIM).transpose(2, 0, 1, 3, 4)

    def block(q_blk):
        s = jnp.einsum('bhqd,bhkd->bhqk', q_blk, kh, preferred_element_type=jnp.float32)
        p = jax.nn.softmax(s, axis=-1).reshape(B, ATT_HEADS, 2, Q_BLOCK, L)
        a = p[:, :, 0] - lam * p[:, :, 1]
        return jnp.einsum('bhqk,bhkv->bhqv', a, vh, preferred_element_type=jnp.float32)

    o = lax.map(block, qb)
    o = o.transpose(1, 0, 3, 2, 4).reshape(B, L, ATT_HEADS, ATT_V_DIM)
    o = rmsnorm(o, subln_g) * (1.0 - lam_init)
    return o.reshape(B, L, ATT_WIDTH).astype(v.dtype)


def setup_inputs(seed: int = 0) -> dict:
    key = jax.random.key(seed)
    ks = jax.random.split(key, 32)
    f32 = jnp.float32

    def nrm(k, shape, scale):
        return jax.random.normal(k, shape, f32) * scale

    Dp = DEPTH
    return {
        "x": nrm(ks[0], (BATCH, SEQ, D_MODEL), 1.0),
        "c": nrm(ks[1], (BATCH, D_MODEL), 1.0),
        "positions": (jnp.arange(SEQ, dtype=jnp.int32)[None, :]
                      + jax.random.randint(ks[2], (BATCH, 1), 0, 4096, dtype=jnp.int32)),
        "w_ada": nrm(ks[3], (Dp, D_MODEL, N_MOD * D_MODEL), 0.5 * D_MODEL ** -0.5),
        "b_ada": nrm(ks[4], (Dp, N_MOD * D_MODEL), 0.01),
        "norm1_g": 1.0 + nrm(ks[5], (Dp, D_MODEL), 0.02),
        "w_in": nrm(ks[6], (Dp, D_MODEL, W_IN_COLS), D_MODEL ** -0.5),
        "hy_conv_w": nrm(ks[7], (Dp, HY_SHORT_CONV, (HY_ORDER + 1) * HY_WIDTH), HY_SHORT_CONV ** -0.5),
        "hy_conv_b": nrm(ks[8], (Dp, (HY_ORDER + 1) * HY_WIDTH), 0.01),
        "hy_filt_w1": nrm(ks[9], (Dp, HY_EMB_DIM, HY_FILTER_HIDDEN), HY_EMB_DIM ** -0.5),
        "hy_filt_b1": nrm(ks[10], (Dp, HY_FILTER_HIDDEN), 0.1),
        "hy_filt_w2": nrm(ks[11], (Dp, HY_FILTER_HIDDEN, HY_FILTER_HIDDEN), HY_FILTER_HIDDEN ** -0.5),
        "hy_filt_b2": nrm(ks[12], (Dp, HY_FILTER_HIDDEN), 0.1),
        "hy_filt_w3": nrm(ks[13], (Dp, HY_FILTER_HIDDEN, HY_FILTER_HIDDEN), HY_FILTER_HIDDEN ** -0.5),
        "hy_filt_b3": nrm(ks[14], (Dp, HY_FILTER_HIDDEN), 0.1),
        "hy_filt_freq": 1.0 + nrm(ks[15], (Dp, 3, HY_FILTER_HIDDEN), 0.1),
        "hy_filt_w_out": nrm(ks[16], (Dp, HY_FILTER_HIDDEN, HY_ORDER * 2 * HY_WIDTH), 0.03 * HY_FILTER_HIDDEN ** -0.5),
        "hy_bias": nrm(ks[17], (Dp, HY_ORDER, HY_WIDTH), 1.0),
        "q_norm_g": 1.0 + nrm(ks[18], (Dp, ATT_HEAD_DIM), 0.02),
        "k_norm_g": 1.0 + nrm(ks[19], (Dp, ATT_HEAD_DIM), 0.02),
        "lam_q1": nrm(ks[20], (Dp, ATT_HEAD_DIM), 0.1),
        "lam_k1": nrm(ks[21], (Dp, ATT_HEAD_DIM), 0.1),
        "lam_q2": nrm(ks[22], (Dp, ATT_HEAD_DIM), 0.1),
        "lam_k2": nrm(ks[23], (Dp, ATT_HEAD_DIM), 0.1),
        "subln_g": 1.0 + nrm(ks[24], (Dp, ATT_V_DIM), 0.02),
        "w_proj_hy": nrm(ks[25], (Dp, HY_WIDTH, D_MODEL), HY_WIDTH ** -0.5),
        "w_proj_att": nrm(ks[26], (Dp, ATT_WIDTH, D_MODEL), ATT_WIDTH ** -0.5),
        "w_out": nrm(ks[27], (Dp, D_MODEL, D_MODEL), D_MODEL ** -0.5),
        "norm2_g": 1.0 + nrm(ks[28], (Dp, D_MODEL), 0.02),
        "w_gate": nrm(ks[29], (Dp, D_MODEL, FFN_HIDDEN), D_MODEL ** -0.5),
        "w_up": nrm(ks[30], (Dp, D_MODEL, FFN_HIDDEN), D_MODEL ** -0.5),
        "w_down": nrm(ks[31], (Dp, FFN_HIDDEN, D_MODEL), FFN_HIDDEN ** -0.5),
    }


def reference(x, c, positions, w_ada, b_ada, norm1_g, w_in, hy_conv_w, hy_conv_b,
              hy_filt_w1, hy_filt_b1, hy_filt_w2, hy_filt_b2, hy_filt_w3, hy_filt_b3,
              hy_filt_freq, hy_filt_w_out, hy_bias, q_norm_g, k_norm_g,
              lam_q1, lam_k1, lam_q2, lam_k2, subln_g, w_proj_hy, w_proj_att, w_out,
              norm2_g, w_gate, w_up, w_down):
    B, L, _ = x.shape
    s_hy = (HY_ORDER + 1) * HY_WIDTH
    s_q = s_hy + ATT_QK_WIDTH
    s_k = s_q + ATT_QK_WIDTH
    s_v = s_k + ATT_WIDTH
    for l in range(DEPTH):
        lam_init = 0.8 - 0.6 * math.exp(-0.3 * l)
        mod = (jax.nn.silu(c) @ w_ada[l] + b_ada[l])[:, None, :]
        sh1, sc1, g1, sh2, sc2, g2 = jnp.split(mod, N_MOD, axis=-1)

        h = rmsnorm(x, norm1_g[l]) * (1.0 + sc1) + sh1
        proj = h @ w_in[l]
        hy_in, q, k, v, gates = jnp.split(proj, [s_hy, s_q, s_k, s_v], axis=-1)

        hy_in = short_conv_centred(hy_in, hy_conv_w[l], hy_conv_b[l])
        hv, hx1, hx2 = jnp.split(hy_in, HY_ORDER + 1, axis=-1)
        filt = hyena_filters(L, hy_filt_w1[l], hy_filt_b1[l], hy_filt_w2[l], hy_filt_b2[l],
                             hy_filt_w3[l], hy_filt_b3[l], hy_filt_freq[l], hy_filt_w_out[l])
        z = hx1 * bidir_long_conv(hv, filt[:, 0, 0], filt[:, 0, 1], hy_bias[l, 0])
        y_hy = hx2 * bidir_long_conv(z, filt[:, 1, 0], filt[:, 1, 1], hy_bias[l, 1])

        lam = (jnp.exp(jnp.sum(lam_q1[l].astype(jnp.float32) * lam_k1[l]))
               - jnp.exp(jnp.sum(lam_q2[l].astype(jnp.float32) * lam_k2[l])) + lam_init)
        y_att = diff_attention(q.reshape(B, L, ATT_HEADS, 2, ATT_HEAD_DIM),
                               k.reshape(B, L, ATT_HEADS, 2, ATT_HEAD_DIM),
                               v.reshape(B, L, ATT_HEADS, ATT_V_DIM),
                               positions, q_norm_g[l], k_norm_g[l], lam, subln_g[l], lam_init)

        g_hy, g_att = jnp.split(jax.nn.sigmoid(gates), N_BRANCHES, axis=-1)
        merged = g_hy * (y_hy @ w_proj_hy[l]) + g_att * (y_att @ w_proj_att[l])
        x = x + g1 * (merged @ w_out[l])

        h2 = rmsnorm(x, norm2_g[l]) * (1.0 + sc2) + sh2
        f = jax.nn.silu(h2 @ w_gate[l]) * (h2 @ w_up[l])
        x = x + g2 * (f @ w_down[l])
    return x
```

```cpp
#include <hip/hip_runtime.h>
#include <hip/hip_cooperative_groups.h>
#include <cstdio>
#include <cstdint>
namespace cg = cooperative_groups;
namespace pg8 {
#define PG8_LAS __attribute__((address_space(3)))
typedef unsigned short bf16_t;
typedef short bf16x8 __attribute__((ext_vector_type(8)));
typedef float f32x4 __attribute__((ext_vector_type(4)));
typedef unsigned u32x4 __attribute__((ext_vector_type(4)));
constexpr int BM = 256, BK = 64, HALF = 128, HTB = HALF * BK * 2  , STAGE_BYTES = 8 * HTB, NXCD = 8, WGM = 8;

__host__ __device__ __forceinline__ int lds_byte(int r, int c) { const int st = (r >> 4) * 2 + (c >> 5), rr = r & 15, cc = c & 31, ob = rr * 64 + cc * 2; return st * 1024 + (ob ^ (((ob >> 9) & 1) << 5)); }
__host__ __device__ __forceinline__ void stage_rc(int b, int& R, int& C) { const int st = b / 1024, sb = b % 1024, swz = sb ^ (((sb >> 9) & 1) << 5); R = (st >> 1) * 16 + swz / 64; C = (st & 1) * 32 + (swz % 64) / 2; }
__host__ __device__ __forceinline__ int perm32(int rho) { const int n = rho >> 4, i = rho & 15; return 8 * (i >> 2) + 4 * n + (i & 3); }

struct Unit { int pm, pn; };
struct Gemm { const bf16_t* A; const bf16_t* Bt; int M, N, K; };

struct StaticOrder {
    int nM, nN, nwg, G, c;
    __host__ __device__ void init(int M, int N, int G_, int c_) { nM = M / BM; nN = N / BM; nwg = nM * nN; G = G_; c = c_; }
    __host__ __device__ bool next(int i, Unit& u) const {
        const long L = (long)i * G + c; if (L >= nwg) return false;
        int wgid = (int)L; { const int q = nwg / NXCD, r = nwg % NXCD, xcd = wgid % NXCD, off = wgid / NXCD; wgid = (xcd < r ? xcd * (q + 1) : r * (q + 1) + (xcd - r) * q) + off; }
        const int nig = WGM * nN, gid = wgid / nig, fm = gid * WGM, gsz = (nM - fm) < WGM ? (nM - fm) : WGM;
        u.pm = fm + ((wgid % nig) % gsz); u.pn = (wgid % nig) / gsz; return true;
    }
    __device__ __forceinline__ void a_ready(const Unit&) const {}
    __device__ __forceinline__ void done(const Unit&) const {}
};

__device__ __forceinline__ unsigned cvt_pk_bf16(float lo, float hi) { unsigned r; asm volatile("v_cvt_pk_bf16_f32 %0, %1, %2" : "=v"(r) : "v"(lo), "v"(hi)); return r; }
#define PG8_F8_SCALES 0x7D79
template <int OFF> __device__ __forceinline__ void pg8_glds16(const char* gbase, unsigned voff, unsigned lds_w) { unsigned keep;
    asm volatile("s_mov_b32 %0, m0\n\ts_add_u32 m0, %3, %4\n\ts_nop 0\n\tglobal_load_lds_dwordx4 %1, %2\n\ts_mov_b32 m0, %0" : "=&s"(keep) : "v"(voff), "s"(gbase), "s"(lds_w), "i"(OFF) : "memory", "scc"); }
typedef short pg8_bf16x16 __attribute__((ext_vector_type(16))); typedef int pg8_i32x8 __attribute__((ext_vector_type(8))); typedef int pg8_i32x4 __attribute__((ext_vector_type(4)));
__device__ __forceinline__ pg8_i32x8 pg8_cat(bf16x8 lo, bf16x8 hi) { const pg8_i32x4 a = __builtin_bit_cast(pg8_i32x4, lo), b = __builtin_bit_cast(pg8_i32x4, hi); return __builtin_shufflevector(a, b, 0, 1, 2, 3, 4, 5, 6, 7); }
__device__ __forceinline__ void pg8_mfma_f8(f32x4& c, const pg8_i32x8 a, const pg8_i32x8 b, const int sc) {
    asm volatile("v_mfma_scale_f32_16x16x128_f8f6f4 %0, %1, %2, %0, %3, %3 op_sel:[0,1,0] op_sel_hi:[0,0,0]" : "+v"(c) : "v"(a), "v"(b), "v"(sc)); }
template <class Epi, class Sched, bool ALIGN_EPI = false, bool SP2 = false, int FP8 = 0>
__device__ __forceinline__ void gemm_phase(PG8_LAS unsigned char* lds, const Gemm g, const Sched& S, const Epi& E, const int wid) {
    int lane_; asm volatile("v_mbcnt_lo_u32_b32 %0, -1, 0\n\tv_mbcnt_hi_u32_b32 %0, -1, %0" : "=v"(lane_)); const int lane = lane_, tid = wid * 64 + lane, wr = wid >> 2, wc = wid & 3, fr = lane & 15, fq = lane >> 4;
    const int K = g.K, nt = K / BK;
    int f8scales = PG8_F8_SCALES; asm volatile("" : "+v"(f8scales));
    unsigned voffA[2], voffB[2];
#pragma unroll
    for (int i = 0; i < 2; ++i) { int R, C; stage_rc(tid * 16 + i * 8192, R, C); const int Rb = Epi::PERM ? ((R & ~31) + perm32(R & 31)) : R;
        voffA[i] = (unsigned)(R * K + C) * 2u; voffB[i] = (unsigned)(Rb * K + C) * 2u; }
    const size_t kstep = (size_t)(BK * 2);
    const size_t hstep = (size_t)HALF * K * 2;
    const size_t tstep = 2 * hstep;
    const unsigned ldsw = (unsigned)wid * 1024u;
    const unsigned lds_w32 = (unsigned)__builtin_amdgcn_readfirstlane((int)((unsigned)(uintptr_t)lds + ldsw));
    const int aoff = lds_byte(wr * 64 + fr, fq * 8), boff = lds_byte(wc * 32 + fr, fq * 8);
#define PG8_SA(b, h) (((b) * 2 + (h)) * HTB)
#define PG8_SB(b, h) ((4 + (b) * 2 + (h)) * HTB)
#define PG8_STAGE(bufoff, gbase, voff) do { pg8_glds16<(bufoff)>((const char*)(gbase), (voff)[0], lds_w32); pg8_glds16<(bufoff) + 8192>((const char*)(gbase), (voff)[1], lds_w32); } while (0)
#define PG8_LDA(dst, b, h) do { _Pragma("unroll") for (int m = 0; m < 4; ++m) { const bf16x8 l_ = *(const PG8_LAS bf16x8*)(lds + PG8_SA(b, h) + aoff + m * 2048), h_ = *(const PG8_LAS bf16x8*)(lds + PG8_SA(b, h) + aoff + m * 2048 + 1024); \
        dst[m] = __builtin_shufflevector(l_, h_, 0, 1, 2, 3, 4, 5, 6, 7, 8, 9, 10, 11, 12, 13, 14, 15); } } while (0)
#define PG8_LDB(dst, b, h) do { _Pragma("unroll") for (int n = 0; n < 2; ++n) { const bf16x8 l_ = *(const PG8_LAS bf16x8*)(lds + PG8_SB(b, h) + boff + n * 2048), h_ = *(const PG8_LAS bf16x8*)(lds + PG8_SB(b, h) + boff + n * 2048 + 1024); \
        dst[n] = __builtin_shufflevector(l_, h_, 0, 1, 2, 3, 4, 5, 6, 7, 8, 9, 10, 11, 12, 13, 14, 15); } } while (0)
#define PG8_LO(v) __builtin_shufflevector(v, v, 0, 1, 2, 3, 4, 5, 6, 7)
#define PG8_HI(v) __builtin_shufflevector(v, v, 8, 9, 10, 11, 12, 13, 14, 15)
#define PG8_MMA(ai, bj, At, Bt) do { __builtin_amdgcn_s_setprio(1); \
        if constexpr (FP8 != 0) {   \
            _Pragma("unroll") for (int m = 0; m < 4; ++m) _Pragma("unroll") for (int n = 0; n < 2; ++n) \
                { if constexpr (FP8 == 2) acc[ai][bj][m][n] = __builtin_amdgcn_mfma_scale_f32_16x16x128_f8f6f4(__builtin_bit_cast(pg8_i32x8, Bt[n]), __builtin_bit_cast(pg8_i32x8, At[m]), acc[ai][bj][m][n], 0, 0, 0, PG8_F8_SCALES, 1, PG8_F8_SCALES); \
                  else pg8_mfma_f8(acc[ai][bj][m][n], __builtin_bit_cast(pg8_i32x8, Bt[n]), __builtin_bit_cast(pg8_i32x8, At[m]), f8scales); } \
        } else { \
            _Pragma("unroll") for (int m = 0; m < 4; ++m) _Pragma("unroll") for (int n = 0; n < 2; ++n) { \
                acc[ai][bj][m][n] = __builtin_amdgcn_mfma_f32_16x16x32_bf16(PG8_LO(Bt[n]), PG8_LO(At[m]), acc[ai][bj][m][n], 0, 0, 0); \
                acc[ai][bj][m][n] = __builtin_amdgcn_mfma_f32_16x16x32_bf16(PG8_HI(Bt[n]), PG8_HI(At[m]), acc[ai][bj][m][n], 0, 0, 0); } } \
        __builtin_amdgcn_s_setprio(0); } while (0)
#define PG8_WAIT_V(n) asm volatile("s_waitcnt vmcnt(" #n ")" ::: "memory")
#define PG8_WAIT_L(n) asm volatile("s_waitcnt lgkmcnt(" #n ")" ::: "memory")
#define PG8_BAR __builtin_amdgcn_s_barrier()
#define PG8_SCHED __builtin_amdgcn_sched_barrier(0)
    Unit cur, nxt; int ui = 0;
    if (!S.next(0, cur)) return;
    f32x4 acc[2][2][4][2];
#pragma unroll
    for (int a = 0; a < 2; ++a)
#pragma unroll
        for (int b = 0; b < 2; ++b)
#pragma unroll
            for (int m = 0; m < 4; ++m)
#pragma unroll
                for (int n = 0; n < 2; ++n) acc[a][b][m][n] = (f32x4){0.f, 0.f, 0.f, 0.f};
    pg8_bf16x16 At[4], B0[2], B1[2];
    const char* cA = (const char*)g.A + (size_t)cur.pm * tstep; const char* cB = (const char*)g.Bt + (size_t)cur.pn * tstep;
    S.a_ready(cur);
    if constexpr (SP2) {
        PG8_STAGE(PG8_SB(0, 0), cB, voffB); PG8_STAGE(PG8_SB(0, 1), cB + hstep, voffB); PG8_STAGE(PG8_SA(0, 0), cA, voffA); PG8_STAGE(PG8_SA(0, 1), cA + hstep, voffA);
        if (wr == 1) PG8_BAR;
        PG8_WAIT_V(2); PG8_BAR;
        PG8_STAGE(PG8_SB(1, 0), cB + kstep, voffB); PG8_STAGE(PG8_SA(1, 0), cA + kstep, voffA); PG8_STAGE(PG8_SB(1, 1), cB + hstep + kstep, voffB);
        PG8_WAIT_V(6); PG8_BAR;
    } else {
        PG8_STAGE(PG8_SB(0, 0), cB, voffB); PG8_STAGE(PG8_SA(0, 0), cA, voffA); PG8_STAGE(PG8_SB(0, 1), cB + hstep, voffB); PG8_STAGE(PG8_SA(0, 1), cA + hstep, voffA);
        if (wr == 1) PG8_BAR;
        PG8_WAIT_V(4); PG8_BAR;
        PG8_STAGE(PG8_SB(1, 0), cB + kstep, voffB); PG8_STAGE(PG8_SA(1, 0), cA + kstep, voffA); PG8_STAGE(PG8_SB(1, 1), cB + hstep + kstep, voffB);
        PG8_WAIT_V(6); PG8_BAR;
    }
    for (;;) {
        const bool has_next = S.next(ui + 1, nxt);
        const char* nA = has_next ? (const char*)g.A + (size_t)nxt.pm * tstep : cA; const char* nB = has_next ? (const char*)g.Bt + (size_t)nxt.pn * tstep : cB;
        for (int t = 0; t < nt; t += 2) {
            const bool last = (t == nt - 2);
            const char* a1 = cA + (size_t)(t + 1) * kstep;
            const char* a2 = last ? nA : cA + (size_t)(t + 2) * kstep; const char* b2 = last ? nB : cB + (size_t)(t + 2) * kstep;
            const char* a3 = a2 + kstep; const char* b3 = b2 + kstep;
            if (last && has_next) S.a_ready(nxt);
            if constexpr (SP2) {
            PG8_LDB(B0, 0, 0); PG8_LDB(B1, 0, 1); PG8_SCHED; PG8_LDA(At, 0, 0); PG8_STAGE(PG8_SA(1, 1), a1 + hstep, voffA);
            PG8_WAIT_V(8); PG8_WAIT_L(0); PG8_BAR; PG8_MMA(0, 0, At, B0); PG8_MMA(0, 1, At, B1); PG8_BAR; PG8_SCHED;
            PG8_LDA(At, 0, 1); PG8_STAGE(PG8_SB(0, 0), b2, voffB); PG8_STAGE(PG8_SB(0, 1), b2 + hstep, voffB); PG8_STAGE(PG8_SA(0, 0), a2, voffA);
            PG8_WAIT_V(8); PG8_WAIT_L(0); PG8_BAR; PG8_MMA(1, 0, At, B0); PG8_MMA(1, 1, At, B1); PG8_BAR; PG8_SCHED;
            PG8_LDB(B0, 1, 0); PG8_LDB(B1, 1, 1); PG8_SCHED; PG8_LDA(At, 1, 0); PG8_STAGE(PG8_SA(0, 1), a2 + hstep, voffA);
            PG8_WAIT_V(8); PG8_WAIT_L(0); PG8_BAR; PG8_MMA(0, 0, At, B0); PG8_MMA(0, 1, At, B1); PG8_BAR; PG8_SCHED;
            PG8_LDA(At, 1, 1); PG8_STAGE(PG8_SB(1, 0), b3, voffB); PG8_STAGE(PG8_SB(1, 1), b3 + hstep, voffB); PG8_STAGE(PG8_SA(1, 0), a3, voffA);
            PG8_WAIT_V(8); PG8_WAIT_L(0); PG8_BAR; PG8_MMA(1, 0, At, B0); PG8_MMA(1, 1, At, B1); PG8_BAR; PG8_SCHED;
            } else {
            PG8_LDB(B0, 0, 0); PG8_SCHED; PG8_LDA(At, 0, 0); PG8_STAGE(PG8_SA(1, 1), a1 + hstep, voffA);
            PG8_WAIT_L(8); PG8_BAR; PG8_WAIT_L(0); PG8_MMA(0, 0, At, B0); PG8_BAR; PG8_SCHED;
            PG8_LDB(B1, 0, 1); PG8_STAGE(PG8_SB(0, 0), b2, voffB);
            PG8_BAR; PG8_WAIT_L(0); PG8_MMA(0, 1, At, B1); PG8_BAR;
            PG8_LDA(At, 0, 1); PG8_STAGE(PG8_SA(0, 0), a2, voffA);
            PG8_BAR; PG8_WAIT_L(0); PG8_MMA(1, 0, At, B0); PG8_BAR; PG8_SCHED;
            PG8_STAGE(PG8_SB(0, 1), b2 + hstep, voffB);
            PG8_WAIT_V(6); PG8_BAR; PG8_MMA(1, 1, At, B1); PG8_BAR;
            PG8_LDB(B0, 1, 0); PG8_SCHED; PG8_LDA(At, 1, 0); PG8_STAGE(PG8_SA(0, 1), a2 + hstep, voffA);
            PG8_WAIT_L(8); PG8_BAR; PG8_WAIT_L(0); PG8_MMA(0, 0, At, B0); PG8_BAR; PG8_SCHED;
            PG8_LDB(B1, 1, 1); PG8_STAGE(PG8_SB(1, 0), b3, voffB);
            PG8_BAR; PG8_WAIT_L(0); PG8_MMA(0, 1, At, B1); PG8_BAR;
            PG8_LDA(At, 1, 1); PG8_STAGE(PG8_SA(1, 0), a3, voffA);
            PG8_BAR; PG8_WAIT_L(0); PG8_MMA(1, 0, At, B0); PG8_BAR; PG8_SCHED;
            PG8_STAGE(PG8_SB(1, 1), b3 + hstep, voffB);
            PG8_WAIT_V(6); PG8_BAR; PG8_MMA(1, 1, At, B1); PG8_BAR;
            }
        }
        if constexpr (ALIGN_EPI) { if (wr == 0) PG8_BAR; }
        if constexpr (FP8 == 1) {
            asm volatile("s_nop 15\n\ts_nop 15\n\ts_nop 7" ::: "memory");
#pragma unroll
            for (int a_ = 0; a_ < 2; ++a_)
#pragma unroll
                for (int b_ = 0; b_ < 2; ++b_)
                    asm volatile("" : "+v"(acc[a_][b_][0][0]), "+v"(acc[a_][b_][0][1]), "+v"(acc[a_][b_][1][0]), "+v"(acc[a_][b_][1][1]), "+v"(acc[a_][b_][2][0]), "+v"(acc[a_][b_][2][1]), "+v"(acc[a_][b_][3][0]), "+v"(acc[a_][b_][3][1]));
        }
        if constexpr (!Epi::AFTER_DRAIN) { E(acc, cur, wr, wc, fr, fq); S.done(cur); }
        if (!has_next) break;
#pragma unroll
        for (int a = 0; a < 2; ++a)
#pragma unroll
            for (int b = 0; b < 2; ++b)
#pragma unroll
                for (int m = 0; m < 4; ++m)
#pragma unroll
                    for (int n = 0; n < 2; ++n) acc[a][b][m][n] = (f32x4){0.f, 0.f, 0.f, 0.f};
        cur = nxt; cA = nA; cB = nB; ++ui;
        if constexpr (ALIGN_EPI) { if (wr == 1) PG8_BAR; }
    }
    PG8_WAIT_V(0);
    if constexpr (!ALIGN_EPI) { if (wr == 0) PG8_BAR; }
    PG8_BAR;
    if constexpr (Epi::AFTER_DRAIN) { E.fused(acc, cur, wr, wc, fr, fq, lds, wid, lane); S.done(cur); }
#undef PG8_SA
#undef PG8_SB
#undef PG8_STAGE
#undef PG8_LDA
#undef PG8_LDB
#undef PG8_MMA
#undef PG8_WAIT_V
#undef PG8_WAIT_L
#undef PG8_BAR
#undef PG8_SCHED
}
}

namespace pg8 {
__device__ __forceinline__ float bf_lo(unsigned w) { return __uint_as_float(w << 16); }
__device__ __forceinline__ float bf_hi(unsigned w) { return __uint_as_float(w & 0xffff0000u); }
__device__ __forceinline__ u32x4 pack8(const f32x4 v0, const f32x4 v1) { u32x4 w; w.x = cvt_pk_bf16(v0[0], v0[1]); w.y = cvt_pk_bf16(v0[2], v0[3]); w.z = cvt_pk_bf16(v1[0], v1[1]); w.w = cvt_pk_bf16(v1[2], v1[3]); return w; }
__device__ __forceinline__ float sigmoidf_(float x) { return __builtin_amdgcn_rcpf(1.0f + __expf(-x)); }

struct EpiPlain {
    static constexpr bool PERM = true, AFTER_DRAIN = false;
    bf16_t* O; int ldc;
    __device__ __forceinline__ void operator()(const f32x4 (&acc)[2][2][4][2], const Unit& u, int wr, int wc, int fr, int fq) const {
        const int row0 = u.pm * BM + wr * 64 + fr, col0 = u.pn * BM + wc * 32 + 8 * fq;
#pragma unroll
        for (int ai = 0; ai < 2; ++ai)
#pragma unroll
            for (int m = 0; m < 4; ++m) { bf16_t* rowp = O + (size_t)(row0 + ai * HALF + m * 16) * ldc + col0;
#pragma unroll
                for (int bj = 0; bj < 2; ++bj) *(u32x4*)(rowp + bj * HALF) = pack8(acc[ai][bj][m][0], acc[ai][bj][m][1]); }
    }
};

struct EpiSig {
    static constexpr bool PERM = true, AFTER_DRAIN = false;
    bf16_t* O; int ldc;
    __device__ __forceinline__ void operator()(const f32x4 (&acc)[2][2][4][2], const Unit& u, int wr, int wc, int fr, int fq) const {
        const int row0 = u.pm * BM + wr * 64 + fr, col0 = u.pn * BM + wc * 32 + 8 * fq;
#pragma unroll
        for (int ai = 0; ai < 2; ++ai)
#pragma unroll
            for (int m = 0; m < 4; ++m) { bf16_t* rowp = O + (size_t)(row0 + ai * HALF + m * 16) * ldc + col0;
#pragma unroll
                for (int bj = 0; bj < 2; ++bj) { f32x4 v0 = acc[ai][bj][m][0], v1 = acc[ai][bj][m][1];
#pragma unroll
                    for (int e = 0; e < 4; ++e) { v0[e] = sigmoidf_(v0[e]); v1[e] = sigmoidf_(v1[e]); }
                    *(u32x4*)(rowp + bj * HALF) = pack8(v0, v1); } }
    }
};

struct EpiFilt {
    static constexpr bool PERM = true, AFTER_DRAIN = false;
    bf16_t* O;
    __device__ __forceinline__ void operator()(const f32x4 (&acc)[2][2][4][2], const Unit& u, int wr, int wc, int fr, int fq) const {
        const int row0 = u.pm * BM + wr * 64 + fr, col0 = u.pn * BM + wc * 32 + 8 * fq;
        const float dmin = -15.350567286626973f, dmax = -3.0701134573253945f;
#pragma unroll
        for (int ai = 0; ai < 2; ++ai)
#pragma unroll
            for (int m = 0; m < 4; ++m) { const int row = row0 + ai * HALF + m * 16; const int c = row & 1023;
                const float delta = fabsf(dmin + (float)c * ((dmax - dmin) / 1023.0f)); const float nd = -delta * (1.0f / 8191.0f);
                bf16_t* rowp = O + (size_t)row * 8192 + col0;
#pragma unroll
                for (int bj = 0; bj < 2; ++bj) { f32x4 v0 = acc[ai][bj][m][0], v1 = acc[ai][bj][m][1]; const int t0 = col0 + bj * HALF;
#pragma unroll
                    for (int e = 0; e < 4; ++e) { v0[e] *= __expf(nd * (float)(t0 + e)); v1[e] *= __expf(nd * (float)(t0 + 4 + e)); }
                    *(u32x4*)(rowp + bj * HALF) = pack8(v0, v1); } }
    }
};

struct EpiProj {
    static constexpr bool PERM = true, AFTER_DRAIN = false;
    bf16_t *Q, *Kb, *V, *G; const float* rope; const float* qg; const float* kg; int pn_off;
    __device__ __forceinline__ void operator()(const f32x4 (&acc)[2][2][4][2], const Unit& u0, int wr, int wc, int fr, int fq) const {
        Unit u; u.pm = u0.pm; u.pn = u0.pn + pn_off;
        const int row0 = u.pm * BM + wr * 64 + fr;
        if (u.pn >= 8) {
            const bool sig = u.pn >= 12;
            bf16_t* base = sig ? G : V; const int ldc = sig ? 4096 : 1024;
            const int col0 = (sig ? (u.pn - 12) : (u.pn - 8)) * BM + wc * 32 + 8 * fq;
#pragma unroll
            for (int ai = 0; ai < 2; ++ai)
#pragma unroll
                for (int m = 0; m < 4; ++m) { bf16_t* rowp = base + (size_t)(row0 + ai * HALF + m * 16) * ldc + col0;
#pragma unroll
                    for (int bj = 0; bj < 2; ++bj) { f32x4 v0 = acc[ai][bj][m][0], v1 = acc[ai][bj][m][1];
                        if (sig) {
#pragma unroll
                            for (int e = 0; e < 4; ++e) { v0[e] = sigmoidf_(v0[e]); v1[e] = sigmoidf_(v1[e]); } }
                        *(u32x4*)(rowp + bj * HALF) = pack8(v0, v1); } }
        } else {
            const bool isq = u.pn < 4; const int pnn = isq ? u.pn : u.pn - 4;
            bf16_t* base = isq ? Q : Kb; const float* g = isq ? qg : kg; const float sc = isq ? 0.125f * 1.4426950408889634f : 1.0f;
            const int head = pnn * 4 + wc;
            f32x4 gv[2][2];
#pragma unroll
            for (int bj = 0; bj < 2; ++bj)
#pragma unroll
                for (int n = 0; n < 2; ++n) gv[bj][n] = *(const f32x4*)(g + 32 * bj + 8 * fq + 4 * n);
#pragma unroll
            for (int ai = 0; ai < 2; ++ai)
#pragma unroll
                for (int m = 0; m < 4; ++m) { const int row = row0 + ai * HALF + m * 16;
                    float ss = 0.f;
#pragma unroll
                    for (int bj = 0; bj < 2; ++bj)
#pragma unroll
                        for (int n = 0; n < 2; ++n) { const f32x4 x = acc[ai][bj][m][n]; ss += (x[0] * x[0] + x[1] * x[1]) + (x[2] * x[2] + x[3] * x[3]); }
                    ss += __shfl_xor(ss, 16); ss += __shfl_xor(ss, 32);
                    const float rinv = rsqrtf(ss * (1.0f / 64.0f) + 1e-6f);
                    f32x4 v[2][2];
#pragma unroll
                    for (int bj = 0; bj < 2; ++bj)
#pragma unroll
                        for (int n = 0; n < 2; ++n) v[bj][n] = acc[ai][bj][m][n] * rinv * gv[bj][n];
                    f32x4 pr[2];
#pragma unroll
                    for (int n = 0; n < 2; ++n)
#pragma unroll
                        for (int e = 0; e < 4; ++e) pr[n][e] = __shfl_xor(v[0][n][e], 16);
                    if (fq < 2) {
                        const float* cs = rope + (size_t)row * 16;
#pragma unroll
                        for (int n = 0; n < 2; ++n) { const f32x4 c01 = *(const f32x4*)(cs + 8 * n), c23 = *(const f32x4*)(cs + 8 * n + 4);
                            const float co[4] = {c01[0], c01[2], c23[0], c23[2]}, si[4] = {c01[1], c01[3], c23[1], c23[3]};
#pragma unroll
                            for (int e = 0; e < 4; ++e) v[0][n][e] = (fq == 0) ? (v[0][n][e] * co[e] - pr[n][e] * si[e]) : (v[0][n][e] * co[e] + pr[n][e] * si[e]); }
                    }
                    bf16_t* rowp = base + (size_t)row * 1024 + head * 64 + 8 * fq;
#pragma unroll
                    for (int bj = 0; bj < 2; ++bj) *(u32x4*)(rowp + 32 * bj) = pack8(v[bj][0] * sc, v[bj][1] * sc); }
        }
    }
};

struct EpiGate1 {
    static constexpr bool PERM = true, AFTER_DRAIN = false;
    bf16_t* T; const bf16_t* G;
    __device__ __forceinline__ void operator()(const f32x4 (&acc)[2][2][4][2], const Unit& u, int wr, int wc, int fr, int fq) const {
        const int row0 = u.pm * BM + wr * 64 + fr, col0 = u.pn * BM + wc * 32 + 8 * fq;
#pragma unroll
        for (int ai = 0; ai < 2; ++ai)
#pragma unroll
            for (int m = 0; m < 4; ++m) { const size_t row = (size_t)(row0 + ai * HALF + m * 16);
#pragma unroll
                for (int bj = 0; bj < 2; ++bj) { const u32x4 gw = *(const u32x4*)(G + row * 4096 + col0 + bj * HALF);
                    f32x4 v0 = acc[ai][bj][m][0], v1 = acc[ai][bj][m][1];
                    v0[0] *= bf_lo(gw.x); v0[1] *= bf_hi(gw.x); v0[2] *= bf_lo(gw.y); v0[3] *= bf_hi(gw.y);
                    v1[0] *= bf_lo(gw.z); v1[1] *= bf_hi(gw.z); v1[2] *= bf_lo(gw.w); v1[3] *= bf_hi(gw.w);
                    *(u32x4*)(T + row * 2048 + col0 + bj * HALF) = pack8(v0, v1); } }
    }
};
struct EpiGate2 {
    static constexpr bool PERM = true, AFTER_DRAIN = false;
    const bf16_t* T; const bf16_t* G; bf16_t* O;
    __device__ __forceinline__ void operator()(const f32x4 (&acc)[2][2][4][2], const Unit& u, int wr, int wc, int fr, int fq) const {
        const int row0 = u.pm * BM + wr * 64 + fr, col0 = u.pn * BM + wc * 32 + 8 * fq;
#pragma unroll
        for (int ai = 0; ai < 2; ++ai)
#pragma unroll
            for (int m = 0; m < 4; ++m) { const size_t row = (size_t)(row0 + ai * HALF + m * 16);
#pragma unroll
                for (int bj = 0; bj < 2; ++bj) { const u32x4 gw = *(const u32x4*)(G + row * 4096 + 2048 + col0 + bj * HALF);
                    const u32x4 tw = *(const u32x4*)(T + row * 2048 + col0 + bj * HALF);
                    f32x4 v0 = acc[ai][bj][m][0], v1 = acc[ai][bj][m][1];
                    v0[0] = v0[0] * bf_lo(gw.x) + bf_lo(tw.x); v0[1] = v0[1] * bf_hi(gw.x) + bf_hi(tw.x); v0[2] = v0[2] * bf_lo(gw.y) + bf_lo(tw.y); v0[3] = v0[3] * bf_hi(gw.y) + bf_hi(tw.y);
                    v1[0] = v1[0] * bf_lo(gw.z) + bf_lo(tw.z); v1[1] = v1[1] * bf_hi(gw.z) + bf_hi(tw.z); v1[2] = v1[2] * bf_lo(gw.w) + bf_lo(tw.w); v1[3] = v1[3] * bf_hi(gw.w) + bf_hi(tw.w);
                    *(u32x4*)(O + row * 2048 + col0 + bj * HALF) = pack8(v0, v1); } }
    }
};
struct EpiRes {
    static constexpr bool PERM = false, AFTER_DRAIN = false;
    const float* base; float* out; const float* gvec; int gstride;
    __device__ __forceinline__ void operator()(const f32x4 (&acc)[2][2][4][2], const Unit& u, int wr, int wc, int, int) const {
        int l_; asm volatile("v_mbcnt_lo_u32_b32 %0, -1, 0\n\tv_mbcnt_hi_u32_b32 %0, -1, %0" : "=v"(l_));
        const int fr = l_ & 15, fq = l_ >> 4;
        const int row0 = u.pm * BM + wr * 64 + fr, col0 = u.pn * BM + wc * 32 + 4 * fq;
        const float* gb = gvec + (size_t)((u.pm * BM) >> 13) * gstride + col0;
#pragma unroll
        for (int bj = 0; bj < 2; ++bj)
#pragma unroll
            for (int n = 0; n < 2; ++n) { const f32x4 gv = *(const f32x4*)(gb + bj * HALF + n * 16);
#pragma unroll
                for (int ai = 0; ai < 2; ++ai)
#pragma unroll
                    for (int m = 0; m < 4; ++m) { const size_t off = (size_t)(row0 + ai * HALF + m * 16) * 2048 + col0 + bj * HALF + n * 16;
                        const f32x4 bs = *(const f32x4*)(base + off);
                        *(f32x4*)(out + off) = bs + gv * acc[ai][bj][m][n]; }
                asm volatile("" ::: "memory"); }
    }
};
struct EpiSwiGLU {
    static constexpr bool PERM = true, AFTER_DRAIN = false;
    unsigned char* F;
    __device__ __forceinline__ void operator()(const f32x4 (&acc)[2][2][4][2], const Unit& u, int wr, int wc, int fr, int fq) const {
        const int row0 = u.pm * BM + wr * 64 + fr, col0 = u.pn * HALF + wc * 32 + 8 * fq;
#pragma unroll
        for (int ai = 0; ai < 2; ++ai)
#pragma unroll
            for (int m = 0; m < 4; ++m) { f32x4 v[2];
#pragma unroll
                for (int n = 0; n < 2; ++n)
#pragma unroll
                    for (int e = 0; e < 4; ++e) { const float gt = acc[ai][0][m][n][e], up = acc[ai][1][m][n][e]; v[n][e] = gt * sigmoidf_(gt) * up * 4.0f; }
                unsigned w0 = 0, w1 = 0;
                w0 = __builtin_amdgcn_cvt_pk_fp8_f32(v[0][0], v[0][1], w0, false); w0 = __builtin_amdgcn_cvt_pk_fp8_f32(v[0][2], v[0][3], w0, true);
                w1 = __builtin_amdgcn_cvt_pk_fp8_f32(v[1][0], v[1][1], w1, false); w1 = __builtin_amdgcn_cvt_pk_fp8_f32(v[1][2], v[1][3], w1, true);
                typedef unsigned u32x2_ __attribute__((ext_vector_type(2)));
                *(u32x2_*)(F + (size_t)(row0 + ai * HALF + m * 16) * 5632 + col0) = (u32x2_){w0, w1}; }
    }
};
}

namespace att {
using bf16x8 = __attribute__((ext_vector_type(8))) short;
using s16x4  = __attribute__((ext_vector_type(4))) short;
using f32x16 = __attribute__((ext_vector_type(16))) float;
using u32x4  = __attribute__((ext_vector_type(4))) unsigned;
typedef unsigned short bf16_t;
constexpr int QBLK = 32, KVBLK = 64, LDQ = 1024, LDK = 1024, LDV = 1024, LDO = 2048, SEQ = 8192;
constexpr int SHM_V = KVBLK * 128 * 2, SHM_K = KVBLK * 64 * 2;
constexpr int NBUF = 4, OFF_V = 0, OFF_K = NBUF * SHM_V, ATT_LDS = NBUF * (SHM_V + SHM_K);
#define AKSWZ(row, colB) ((row) * 128 + ((colB) ^ (((row) & 7) << 4)))
#define ASBAR() __builtin_amdgcn_sched_barrier(0)
__device__ __forceinline__ int crow(int r, int hi) { return (r & 3) + 8 * (r >> 2) + 4 * hi; }
__device__ __forceinline__ unsigned cvtpk(float lo, float hi) { unsigned r; asm volatile("v_cvt_pk_bf16_f32 %0, %1, %2" : "=v"(r) : "v"(lo), "v"(hi)); return r; }

__device__ __forceinline__ void partialSM(f32x16& p0, f32x16& p1, float sh) {
  if (sh != 0.f) {
#pragma unroll
    for (int r = 0; r < 16; ++r) { p0[r] -= sh; p1[r] -= sh; }
  }
#pragma unroll
  for (int r = 0; r < 16; ++r) p0[r] = __builtin_amdgcn_exp2f(p0[r]);
}
__device__ __forceinline__ void finishSM(f32x16& p0, f32x16& p1, bf16x8& pa0, bf16x8& pa1, bf16x8& pa2, bf16x8& pa3) {
#pragma unroll
  for (int r = 0; r < 16; ++r) p1[r] = __builtin_amdgcn_exp2f(p1[r]);
#define APK4(P, BASE, OUT) do { unsigned a0 = cvtpk(P[BASE + 0], P[BASE + 1]), a1 = cvtpk(P[BASE + 2], P[BASE + 3]);   \
    unsigned b0 = cvtpk(P[BASE + 4], P[BASE + 5]), b1 = cvtpk(P[BASE + 6], P[BASE + 7]);                              \
    auto r0 = __builtin_amdgcn_permlane32_swap(a0, b0, false, false); auto r1 = __builtin_amdgcn_permlane32_swap(a1, b1, false, false); \
    u32x4 w = {r0[0], r1[0], r0[1], r1[1]}; OUT = *reinterpret_cast<bf16x8*>(&w); } while (0)
  APK4(p0, 0, pa0); APK4(p0, 8, pa1); APK4(p1, 0, pa2); APK4(p1, 8, pa3);
#undef APK4
}
__device__ __forceinline__ void qkt(f32x16& p0, f32x16& p1, const char* Ks, const bf16x8* qr, int r32, int hi) {
  p0 = f32x16{}; p1 = f32x16{};
#pragma unroll
  for (int d0 = 0; d0 < 4; ++d0) { const int cb = (d0 * 16 + hi * 8) * 2;
    bf16x8 b0 = *reinterpret_cast<const bf16x8*>(Ks + AKSWZ(r32, cb));
    bf16x8 b1 = *reinterpret_cast<const bf16x8*>(Ks + AKSWZ(32 + r32, cb));
    p0 = __builtin_amdgcn_mfma_f32_32x32x16_bf16(b0, qr[d0], p0, 0, 0, 0);
    p1 = __builtin_amdgcn_mfma_f32_32x32x16_bf16(b1, qr[d0], p1, 0, 0, 0); }
}
__device__ __forceinline__ int v_st(int k, int c) { const int kk = (k & ~0xC) | ((k & 4) << 1) | ((k & 8) >> 1); return ((kk >> 3) * 4 + (c >> 5)) * 512 + ((kk & 7) * 32 + (c & 31)) * 2; }
__device__ __forceinline__ int v_rd_base(int lane) { return ((lane & 3) << 3) | (((lane >> 2) & 3) << 6) | (((lane >> 4) & 1) << 5) | (((lane >> 5) & 1) << 8); }
constexpr int v_rd_off(int d0, int ks, int half) { return d0 * 512 + ks * 4096 + half * 2048; }
template <int OFF> __device__ __forceinline__ s16x4 tr_read(int vb) {
  s16x4 r; asm volatile("ds_read_b64_tr_b16 %0, %1 offset:%2" : "=&v"(r) : "v"(vb), "i"(OFF) : "memory"); return r;
}
template <int KS> __device__ __forceinline__ void pv_ks(f32x16* o, f32x16& osum, int vb, bf16x8 pa) {
  const s16x4 l0 = tr_read<v_rd_off(0, KS, 0)>(vb), h0 = tr_read<v_rd_off(0, KS, 1)>(vb), l1 = tr_read<v_rd_off(1, KS, 0)>(vb), h1 = tr_read<v_rd_off(1, KS, 1)>(vb);
  const s16x4 l2 = tr_read<v_rd_off(2, KS, 0)>(vb), h2 = tr_read<v_rd_off(2, KS, 1)>(vb), l3 = tr_read<v_rd_off(3, KS, 0)>(vb), h3 = tr_read<v_rd_off(3, KS, 1)>(vb);
  const bf16x8 ones = (bf16x8){0x3F80, 0x3F80, 0x3F80, 0x3F80, 0x3F80, 0x3F80, 0x3F80, 0x3F80};
  osum = __builtin_amdgcn_mfma_f32_32x32x16_bf16(pa, ones, osum, 0, 0, 0);
  asm volatile("s_waitcnt lgkmcnt(0)" ::: "memory"); ASBAR();
#define APK(L, H) (bf16x8){L[0], L[1], L[2], L[3], H[0], H[1], H[2], H[3]}
  o[0] = __builtin_amdgcn_mfma_f32_32x32x16_bf16(pa, APK(l0, h0), o[0], 0, 0, 0);
  o[1] = __builtin_amdgcn_mfma_f32_32x32x16_bf16(pa, APK(l1, h1), o[1], 0, 0, 0);
  o[2] = __builtin_amdgcn_mfma_f32_32x32x16_bf16(pa, APK(l2, h2), o[2], 0, 0, 0);
  o[3] = __builtin_amdgcn_mfma_f32_32x32x16_bf16(pa, APK(l3, h3), o[3], 0, 0, 0);
#undef APK
}
__device__ __forceinline__ void pv_d0(f32x16* o, f32x16& osum, int vb, bf16x8 pa0, bf16x8 pa1, bf16x8 pa2, bf16x8 pa3) {
  pv_ks<0>(o, osum, vb, pa0); pv_ks<1>(o, osum, vb, pa1); pv_ks<2>(o, osum, vb, pa2); pv_ks<3>(o, osum, vb, pa3);
}

__device__ __forceinline__ void attn_unit(const bf16_t* __restrict__ Qb, const bf16_t* __restrict__ Kh, const bf16_t* __restrict__ Vh, bf16_t* __restrict__ Ob, char* lds, const int wid, const float sh, const int kmul) {
  int lane_; asm volatile("v_mbcnt_lo_u32_b32 %0, -1, 0\n\tv_mbcnt_hi_u32_b32 %0, -1, %0" : "=v"(lane_)); const int lane = lane_, tid = wid * 64 + lane, r32 = lane & 31, hi = lane >> 5;
  char* V_lds = lds + OFF_V; char* K_lds = lds + OFF_K;
  f32x16 o[4] = {}; f32x16 osum = {}; bf16x8 qr[4];
  const bf16_t* Qw = Qb + (long)(wid * QBLK + r32) * LDQ + hi * 8;
#pragma unroll
  for (int d0 = 0; d0 < 4; ++d0) qr[d0] = *reinterpret_cast<const bf16x8*>(Qw + d0 * 16);
  const int sr = tid >> 4, sc = (tid & 15) * 8, vst0 = v_st(sr, sc);
  const int kr = tid >> 3, kc = (tid & 7) * 8, kst = AKSWZ(kr, kc * 2);
  const int vb0 = (int)(uintptr_t)V_lds + v_rd_base(lane);
  struct { bf16x8 vs0, vs1, ks0; } sr_[2];
  const unsigned voffB = (unsigned)(sr * LDV + sc) * 2u, koffB = (unsigned)(kr * LDK + kc) * 2u;
#define ASLOAD(i, k0) do { const char* vt_ = (const char*)Vh + (size_t)((k0) * kmul) * (LDV * 2); const char* kt_ = (const char*)Kh + (size_t)((k0) * kmul) * (LDK * 2); \
    sr_[i].vs0 = *reinterpret_cast<const bf16x8*>(vt_ + voffB); sr_[i].vs1 = *reinterpret_cast<const bf16x8*>(vt_ + 32 * LDV * 2 + voffB); \
    sr_[i].ks0 = *reinterpret_cast<const bf16x8*>(kt_ + koffB); } while (0)
#define ASWRITE(b, i) do { *(bf16x8*)(V_lds + (b) * SHM_V + vst0) = sr_[i].vs0; *(bf16x8*)(V_lds + (b) * SHM_V + 8192 + vst0) = sr_[i].vs1; \
    *(bf16x8*)(K_lds + (b) * SHM_K + kst) = sr_[i].ks0; } while (0)
#define ASWAIT() asm volatile("s_waitcnt vmcnt(3)" ::: "memory")
  f32x16 pA0, pA1, pB0, pB1; bf16x8 pa0, pa1, pa2, pa3; constexpr int NT = SEQ / KVBLK;
#define ALOADSTEP(j, SL) do { if ((j) + 2 < NT) { ASWAIT(); ASWRITE(((j) + 2) & 3, SL); } if ((j) + 4 < NT) ASLOAD(SL, ((j) + 4) * KVBLK); } while (0)
#define AH1(j, X0, X1, Y0, Y1) do { ASBAR(); qkt(X0, X1, K_lds + ((j) & 3) * SHM_K, qr, r32, hi); finishSM(Y0, Y1, pa0, pa1, pa2, pa3); ASBAR(); } while (0)
#define AH2(j, X0, X1) do { pv_d0(o, osum, vb0 + (((j) - 1) & 3) * SHM_V, pa0, pa1, pa2, pa3); partialSM(X0, X1, sh); } while (0)
  ASLOAD(0, 0); ASLOAD(1, KVBLK); asm volatile("s_waitcnt vmcnt(0)" ::: "memory"); ASWRITE(0, 0); ASWRITE(1, 1);
  ASLOAD(0, 2 * KVBLK); ASLOAD(1, 3 * KVBLK);
  __syncthreads();
  if (wid < 4) {
    ALOADSTEP(0, 0); qkt(pA0, pA1, K_lds, qr, r32, hi); partialSM(pA0, pA1, sh); __syncthreads();
    for (int j = 1; j + 1 < NT; j += 2) {
      ALOADSTEP(j, 1); AH1(j, pB0, pB1, pA0, pA1); AH2(j, pB0, pB1); __syncthreads();
      ALOADSTEP(j + 1, 0); AH1(j + 1, pA0, pA1, pB0, pB1); AH2(j + 1, pA0, pA1); __syncthreads();
    }
    AH1(NT - 1, pB0, pB1, pA0, pA1); AH2(NT - 1, pB0, pB1); __syncthreads();
    finishSM(pB0, pB1, pa0, pa1, pa2, pa3); ASBAR();
  } else {
    qkt(pA0, pA1, K_lds, qr, r32, hi);
    ALOADSTEP(0, 0); partialSM(pA0, pA1, sh); AH1(1, pB0, pB1, pA0, pA1); __syncthreads();
    for (int j = 1; j + 1 < NT; j += 2) {
      ALOADSTEP(j, 1); AH2(j, pB0, pB1); AH1(j + 1, pA0, pA1, pB0, pB1); __syncthreads();
      ALOADSTEP(j + 1, 0); AH2(j + 1, pA0, pA1); AH1(j + 2, pB0, pB1, pA0, pA1); __syncthreads();
    }
    AH2(NT - 1, pB0, pB1); finishSM(pB0, pB1, pa0, pa1, pa2, pa3); ASBAR(); __syncthreads();
  }
  pv_d0(o, osum, vb0 + ((NT - 1) & 3) * SHM_V, pa0, pa1, pa2, pa3);
#undef ALOADSTEP
#undef AH1
#undef AH2
  int le_; asm volatile("v_mbcnt_lo_u32_b32 %0, -1, 0\n\tv_mbcnt_hi_u32_b32 %0, -1, %0" : "=v"(le_));
  const int r32e = le_ & 31, hie = le_ >> 5;
  bf16_t* Ow = Ob + (long)(wid * QBLK) * LDO + r32e;
#pragma unroll
  for (int r = 0; r < 16; ++r) { const int orow = crow(r, hie); const float rl = __builtin_amdgcn_rcpf(osum[r]);
#pragma unroll
    for (int d0 = 0; d0 < 4; ++d0) Ow[(long)orow * LDO + d0 * 32] = (bf16_t)(cvtpk(o[d0][r] * rl, 0.f) & 0xffffu); }
  __syncthreads();
#undef ASLOAD
#undef ASWRITE
#undef ASWAIT
}
}

#define LAS __attribute__((address_space(3)))
typedef unsigned short bf16;
typedef unsigned v4u __attribute__((ext_vector_type(4)));
typedef unsigned v2u __attribute__((ext_vector_type(2)));
typedef float f32x4 __attribute__((ext_vector_type(4)));
constexpr int NWAVES = 8, NTHR = 512;
constexpr int DM = 2048, SEQ = 8192, MTOK = 16384, HYW = 1024, FFH = 5632, NMOD = 12288, WINC = 10240;
constexpr int LDS_BYTES = 147456, RING_BYTES = 131072;
constexpr size_t MiB = 1u << 20;
constexpr size_t WS_MODP = 0;
constexpr size_t WS_MOD  = 1572864;
constexpr size_t WS_BAR  = 1835008;
constexpr size_t WS_ROPE = 2 * MiB;
constexpr size_t WS_H3   = 3 * MiB;
constexpr size_t WS_WTF  = 5 * MiB;
constexpr size_t WS_WTHY = 6 * MiB;
constexpr size_t WS_WTRE = 18 * MiB;
constexpr size_t WS_WTPH = 46 * MiB;
constexpr size_t WS_WTPA = 50 * MiB;
constexpr size_t WS_WTO  = 54 * MiB;
constexpr size_t WS_WTGU = 62 * MiB;
constexpr size_t WS_WTDN = 106 * MiB;
constexpr size_t WS_ACT  = 128 * MiB;
constexpr size_t WS_HYT  = 192 * MiB;
constexpr size_t WS_Q    = 288 * MiB, WS_K = 320 * MiB, WS_V = 352 * MiB;
constexpr size_t WS_FILT = 384 * MiB;
constexpr size_t WS_OC   = 448 * MiB;
constexpr size_t WS_WTG8 = 38 * MiB;
constexpr size_t WS_H8   = 480 * MiB;
constexpr size_t WS_YHYT = 6 * MiB;
constexpr size_t WS_YHY  = 192 * MiB, WS_YATT = 224 * MiB;
constexpr size_t WS_T    = 288 * MiB;
constexpr size_t WS_F    = 192 * MiB;
constexpr size_t WS_END  = 512 * MiB;

struct Args { const void* in[32]; float* out; unsigned char* ws; int ph_lo, ph_hi; int rep[12]; };

template <int OFF> __device__ __forceinline__ const void* karg_ptr() { unsigned long long p; asm volatile("s_load_dwordx2 %0, %1, %2\n\ts_waitcnt lgkmcnt(0)" : "=s"(p) : "s"(__builtin_amdgcn_kernarg_segment_ptr()), "i"(OFF) : "memory");
    return (const void*)(__attribute__((address_space(1))) const void*)p; }
template <int OFF> __device__ __forceinline__ int karg_int() { int v; asm volatile("s_load_dword %0, %1, %2\n\ts_waitcnt lgkmcnt(0)" : "=s"(v) : "s"(__builtin_amdgcn_kernarg_segment_ptr()), "i"(OFF) : "memory"); return v; }
__device__ __forceinline__ int lane_id() { int l; asm volatile("v_mbcnt_lo_u32_b32 %0, -1, 0\n\tv_mbcnt_hi_u32_b32 %0, -1, %0" : "=v"(l)); return l; }
#define LANE_TID const int lane = lane_id(), tid = wave * 64 + lane; (void)tid; (void)lane
#define KARG(i) (karg_ptr<8 * (i)>())
#define KOUT ((float*)karg_ptr<256>())
#define KWS ((unsigned char*)karg_ptr<264>())
#define KARGI(off) (karg_int<off>())


__device__ __forceinline__ float wave_sum(float v) {
#pragma unroll
    for (int o = 1; o < 64; o <<= 1) v += __shfl_xor(v, o);
    return v;
}
__device__ __forceinline__ unsigned f2bf(float f) { unsigned u = __builtin_bit_cast(unsigned, f); return (u + 0x7fffu + ((u >> 16) & 1u)) >> 16; }
__device__ __forceinline__ unsigned pk2(float lo, float hi) { return f2bf(lo) | (f2bf(hi) << 16); }
__device__ __forceinline__ float bflo(unsigned w) { return __uint_as_float(w << 16); }
__device__ __forceinline__ float bfhi(unsigned w) { return __uint_as_float(w & 0xffff0000u); }

template <class RowMap>
__device__ __forceinline__ void transpose_item(const float* W, int K, int N, bf16* WT, int ldk, RowMap rowmap, LAS float* scr, int item, int lane) {
    const int nblk = N / 32, kb = item / nblk, nb = item % nblk, k0 = 64 * kb, n0 = 32 * nb;
#pragma unroll 8
    for (int i = 0; i < 32; ++i) { const int kk = 2 * i + (lane >> 5); scr[kk * 33 + (lane & 31)] = W[(size_t)(k0 + kk) * N + n0 + (lane & 31)]; }
    asm volatile("s_waitcnt lgkmcnt(0)" ::: "memory");
    const int c = lane & 7;
    const int rbase = rowmap(n0);
#pragma unroll
    for (int j = 0; j < 4; ++j) { const int n = (lane >> 3) + 8 * j; const LAS float* s = scr + (8 * c) * 33 + n;
        v4u o; o.x = pk2(s[0 * 33], s[1 * 33]); o.y = pk2(s[2 * 33], s[3 * 33]); o.z = pk2(s[4 * 33], s[5 * 33]); o.w = pk2(s[6 * 33], s[7 * 33]);
        *(v4u*)(WT + (size_t)(rbase + n) * ldk + k0 + 8 * c) = o; }
    asm volatile("s_waitcnt lgkmcnt(0)" ::: "memory");
}
__device__ __forceinline__ unsigned pk4_fp8(float a, float b, float c, float d) { unsigned w = 0; w = __builtin_amdgcn_cvt_pk_fp8_f32(a, b, w, false); w = __builtin_amdgcn_cvt_pk_fp8_f32(c, d, w, true); return w; }
template <class RowMap>
__device__ __forceinline__ void transpose_item_fp8(const float* W, int K, int N, unsigned char* WT8, int ldk, RowMap rowmap, float scale, LAS float* scr, int item, int lane) {
    const int nblk = N / 32, kb = item / nblk, nb = item % nblk, k0 = 64 * kb, n0 = 32 * nb;
#pragma unroll 8
    for (int i = 0; i < 32; ++i) { const int kk = 2 * i + (lane >> 5); scr[kk * 33 + (lane & 31)] = W[(size_t)(k0 + kk) * N + n0 + (lane & 31)] * scale; }
    asm volatile("s_waitcnt lgkmcnt(0)" ::: "memory");
    const int c = lane & 7;
    const int rbase = rowmap(n0);
#pragma unroll
    for (int j = 0; j < 4; ++j) { const int n = (lane >> 3) + 8 * j; const LAS float* s = scr + (8 * c) * 33 + n;
        v2u o; o.x = pk4_fp8(s[0 * 33], s[1 * 33], s[2 * 33], s[3 * 33]); o.y = pk4_fp8(s[4 * 33], s[5 * 33], s[6 * 33], s[7 * 33]);
        *(v2u*)(WT8 + (size_t)(rbase + n) * ldk + k0 + 8 * c) = o; }
    asm volatile("s_waitcnt lgkmcnt(0)" ::: "memory");
}
struct MapId { int off; __device__ __forceinline__ int operator()(int n) const { return n + off; } };
struct MapWin {
    __device__ __forceinline__ int operator()(int n) const {
        if (n < 3072) return n;
        const int r = n - 3072, pn = r >> 8;
        if (pn >= 8) return n;
        const int fe = r & 255, wc = fe >> 6, bj = (fe >> 5) & 1, i = fe & 31;
        return 3072 + (pn << 8) + 128 * bj + 32 * wc + i;
    }
};
struct MapGU { int up; __device__ __forceinline__ int operator()(int n) const { return ((n >> 7) << 8) + 128 * up + (n & 127); } };

__device__ __forceinline__ void phase0(LAS unsigned char* lds, int wave) {
    LANE_TID;
    unsigned char* ws = KWS;
    const int G = gridDim.x, bx = blockIdx.x;
    const int gw = wave * G + bx, NGW = G * NWAVES;
    const int gt = bx * NTHR + tid, NGT = G * NTHR;
    {
        const int* pos = (const int*)KARG(2); float* rope = (float*)(ws + WS_ROPE);
        for (int idx = gt; idx < MTOK * 8; idx += NGT) {
            const int tok = idx >> 3, i = idx & 7;
            const double inv = exp2(-(double)i * 0.125 * 18.931568569324174);
            double ang = (double)pos[tok] * inv;
            ang -= 6.283185307179586476925 * rint(ang * 0.15915494309189533577);
            float s, c; sincosf((float)ang, &s, &c);
            rope[2 * idx] = c; rope[2 * idx + 1] = s;
        }
    }
    {
        LAS float* w1s = (LAS float*)lds;
        LAS float* w2s = w1s + 33 * 64;
        LAS float* w3s = w2s + 64 * 64;
        LAS float* zb  = w3s + 64 * 64 + wave * 64;
        const float* w1 = (const float*)KARG(9); const float* b1 = (const float*)KARG(10); const float* w2 = (const float*)KARG(11); const float* b2 = (const float*)KARG(12);
        const float* w3 = (const float*)KARG(13); const float* b3 = (const float*)KARG(14); const float* fr = (const float*)KARG(15);
        for (int i = tid; i < 33 * 64; i += NTHR) w1s[i] = w1[i];
        for (int i = tid; i < 64 * 64; i += NTHR) { w2s[i] = w2[i]; w3s[i] = w3[i]; }
        __syncthreads();
        const float bb1 = b1[lane], bb2 = b2[lane], bb3 = b3[lane], f0 = fr[lane], f1 = fr[64 + lane], f2 = fr[128 + lane];
        bf16* H3 = (bf16*)(ws + WS_H3);
        const int iters = (SEQ + NGW - 1) / NGW;
        for (int it = 0; it < iters; ++it) {
            const int n = gw + it * NGW; const bool act = n < SEQ;
            float z = 0.f;
            if (lane == 0) z = (float)((double)n / 8191.0);
            else if (lane < 33) { const int bi = (lane - 1) & 15; const double band = 1e-4 + (double)bi * ((15.0 - 1e-4) / 15.0);
                double ang = band * (6.283185307179586476925 * (double)n / 8192.0); ang -= 6.283185307179586476925 * rint(ang * 0.15915494309189533577);
                z = (lane < 17) ? cosf((float)ang) : -sinf((float)ang); }
            zb[lane] = z; __syncthreads();
            float acc = bb1;
#pragma unroll
            for (int i = 0; i < 33; ++i) acc += zb[i] * w1s[i * 64 + lane];
            float h = sinf(f0 * acc); __syncthreads();
            zb[lane] = h; __syncthreads();
            acc = bb2;
#pragma unroll 16
            for (int i = 0; i < 64; ++i) acc += zb[i] * w2s[i * 64 + lane];
            h = sinf(f1 * acc); __syncthreads();
            zb[lane] = h; __syncthreads();
            acc = bb3;
#pragma unroll 16
            for (int i = 0; i < 64; ++i) acc += zb[i] * w3s[i * 64 + lane];
            h = sinf(f2 * acc); __syncthreads();
            if (act) { H3[(size_t)n * 128 + lane] = (bf16)f2bf(h); H3[(size_t)n * 128 + 64 + lane] = 0; }
        }
        __syncthreads();
    }
    LAS float* scs = (LAS float*)(lds + 8 * 8448);
    { const float* c = (const float*)KARG(1);
      for (int i = tid; i < 2 * DM; i += NTHR) { const float v = c[i]; scs[i] = v / (1.0f + __expf(-v)); }
      __syncthreads(); }
    if (gw < 768) {
        const int s = gw / 48, cgp = gw % 48;
        const float* w = (const float*)KARG(3) + (size_t)(s * 128) * NMOD + cgp * 256 + lane * 4;
        f32x4 a0 = {0.f, 0.f, 0.f, 0.f}, a1 = {0.f, 0.f, 0.f, 0.f};
#pragma unroll 8
        for (int k = 0; k < 128; ++k) { const f32x4 wv = *(const f32x4*)(w + (size_t)k * NMOD); const float c0 = scs[s * 128 + k], c1 = scs[DM + s * 128 + k]; a0 += wv * c0; a1 += wv * c1; }
        float* mp = (float*)(ws + WS_MODP) + (size_t)s * 2 * NMOD + cgp * 256 + lane * 4;
        *(f32x4*)mp = a0; *(f32x4*)(mp + NMOD) = a1;
    }
    {
        LAS float* scr = (LAS float*)(lds + wave * 8448);
        constexpr int I_IN = 32 * 320, I_PH = 16 * 64, I_PA = 16 * 64, I_O = 32 * 64, I_G = 32 * 176, I_U = 32 * 176, I_D = 88 * 64, I_F = 128;
        constexpr int NIT = I_IN + I_PH + I_PA + I_O + I_G + I_U + I_D + I_F;
        const int nada = (NGW > 768) ? 768 : 0; const int per_ada = 5; const int nrest = NGW - nada;
        int it, step, cnt;
        if (gw < nada) { it = gw * per_ada; step = 1; cnt = per_ada; }
        else { it = nada * per_ada + (gw - nada); step = nrest; cnt = 0x7fffffff; }
        for (int q = 0; q < cnt && it < NIT; ++q, it += step) {
            int r = it;
            if (r < I_IN) { if ((r % 320) >= 192) transpose_item_fp8((const float*)KARG(6), DM, WINC, ws + WS_WTG8, DM, MapId{-6144}, 64.0f, scr, r, lane);
                            else transpose_item((const float*)KARG(6), DM, WINC, (bf16*)(ws + WS_WTHY), DM, MapWin{}, scr, r, lane); continue; } r -= I_IN;
            if (r < I_PH) { transpose_item((const float*)KARG(25), HYW, DM, (bf16*)(ws + WS_WTPH), HYW, MapId{0}, scr, r, lane); continue; } r -= I_PH;
            if (r < I_PA) { transpose_item((const float*)KARG(26), HYW, DM, (bf16*)(ws + WS_WTPA), HYW, MapId{0}, scr, r, lane); continue; } r -= I_PA;
            if (r < I_O)  { transpose_item((const float*)KARG(27), DM, DM, (bf16*)(ws + WS_WTO), DM, MapId{0}, scr, r, lane); continue; } r -= I_O;
            if (r < I_G)  { transpose_item_fp8((const float*)KARG(29), DM, FFH, ws + WS_WTGU, DM, MapGU{0}, 64.0f, scr, r, lane); continue; } r -= I_G;
            if (r < I_U)  { transpose_item_fp8((const float*)KARG(30), DM, FFH, ws + WS_WTGU, DM, MapGU{1}, 64.0f, scr, r, lane); continue; } r -= I_U;
            if (r < I_D)  { transpose_item_fp8((const float*)KARG(31), FFH, DM, ws + WS_WTDN, FFH, MapId{0}, 64.0f, scr, r, lane); continue; } r -= I_D;
            { transpose_item((const float*)KARG(16), 64, 4096, (bf16*)(ws + WS_WTF), 128, MapId{0}, scr, r, lane);
              const int n0 = 32 * r; bf16* wt = (bf16*)(ws + WS_WTF);
#pragma unroll
              for (int j = 0; j < 4; ++j) { const int n = (lane >> 3) + 8 * j; *(v4u*)(wt + (size_t)(n0 + n) * 128 + 64 + 8 * (lane & 7)) = (v4u){0u, 0u, 0u, 0u}; } }
        }
    }
    __syncthreads();
}

template <int FP8OUT>
__device__ __forceinline__ void norm_rows(const float* X, void* Ov, void* Ov8, LAS float* fac, LAS float* sh, int gw, int NGW, int lane) {
    for (int m = gw; m < MTOK; m += NGW) {
        const f32x4* xr = (const f32x4*)(X + (size_t)m * DM) + lane;
        f32x4 v[8]; float s = 0.f;
#pragma unroll
        for (int j = 0; j < 8; ++j) { v[j] = xr[64 * j]; s += (v[j].x * v[j].x + v[j].y * v[j].y) + (v[j].z * v[j].z + v[j].w * v[j].w); }
        const float rinv = rsqrtf(wave_sum(s) * (1.0f / DM) + 1e-6f);
        const int b = m >> 13;
        const LAS f32x4* fp = (const LAS f32x4*)(fac + b * DM) + lane; const LAS f32x4* sp = (const LAS f32x4*)(sh + b * DM) + lane;
        if constexpr (FP8OUT != 0) {
            unsigned* o4 = (unsigned*)((unsigned char*)(FP8OUT == 2 ? Ov8 : Ov) + (size_t)m * DM) + lane;
#pragma unroll
            for (int j = 0; j < 8; ++j) { const f32x4 f = fp[64 * j], t = sp[64 * j]; const f32x4 y = (v[j] * rinv * f + t) * 4.0f; o4[64 * j] = pk4_fp8(y.x, y.y, y.z, y.w); }
        }
        if constexpr (FP8OUT != 1) {
        v2u* o8 = (v2u*)((bf16*)Ov + (size_t)m * DM) + lane;
#pragma unroll
        for (int j = 0; j < 8; ++j) { const f32x4 f = fp[64 * j], t = sp[64 * j]; const f32x4 y = v[j] * rinv * f + t;
            v2u w; w.x = pk2(y.x, y.y); w.y = pk2(y.z, y.w); o8[64 * j] = w; }
        }
    }
}
__device__ __forceinline__ float mod_from_partials(const float* modp, const float* b_ada, int b, int j) {
    float s = b_ada[j];
#pragma unroll
    for (int k = 0; k < 16; ++k) s += modp[(size_t)(k * 2 + b) * NMOD + j];
    return s;
}

#define FFT_DEV __device__ __forceinline__
#define FFT_LAS LAS
#define FFT_SYNC() __syncthreads()
#define FFT_LAUNDER(x) asm volatile("" : "+v"(x))

typedef float f32x2 __attribute__((ext_vector_type(2)));
FFT_DEV int fswz(int e) { return e ^ (((e >> 5) & 1) | (((e >> 6) & 1) * 6) | (((e >> 7) & 3) << 3)); }
FFT_DEV f32x2 cmul(f32x2 a, f32x2 b) { return (f32x2){a.x * b.x - a.y * b.y, a.x * b.y + a.y * b.x}; }
FFT_DEV f32x2 cmulc(f32x2 a, f32x2 b) { return (f32x2){a.x * b.x + a.y * b.y, a.y * b.x - a.x * b.y}; }
FFT_DEV void f4_fwd(f32x2& a0, f32x2& a1, f32x2& a2, f32x2& a3) {
    const f32x2 t0 = a0 + a2, t1 = a0 - a2, t2 = a1 + a3, d = a1 - a3, t3 = (f32x2){d.y, -d.x};
    a0 = t0 + t2; a1 = t1 + t3; a2 = t0 - t2; a3 = t1 - t3;
}
FFT_DEV void f4_inv(f32x2& a0, f32x2& a1, f32x2& a2, f32x2& a3) {
    const f32x2 t0 = a0 + a2, t1 = a0 - a2, t2 = a1 + a3, d = a1 - a3, t3 = (f32x2){-d.y, d.x};
    a0 = t0 + t2; a1 = t1 + t3; a2 = t0 - t2; a3 = t1 - t3;
}
FFT_DEV int fft_rev4(int e) { const unsigned r = __builtin_bitreverse32((unsigned)e) >> 18; return (int)(((r & 0x1555u) << 1) | ((r >> 1) & 0x1555u)); }
FFT_DEV int fft_partner_slot(int p) { const int f = fft_rev4(fswz(p)); return fswz(fft_rev4((16384 - f) & 16383)); }
#define FFT_C16R(k) ((k) == 0 ? 1.0f : (k) == 1 ? 0.92387953251128674f : (k) == 2 ? 0.70710678118654752f : (k) == 3 ? 0.38268343236508977f : (k) == 4 ? 0.0f : (k) == 6 ? -0.70710678118654752f :   -0.92387953251128674f)
#define FFT_C16I(k) ((k) == 0 ? 0.0f : (k) == 1 ? -0.38268343236508977f : (k) == 2 ? -0.70710678118654752f : (k) == 3 ? -0.92387953251128674f : (k) == 4 ? -1.0f : (k) == 6 ? -0.70710678118654752f :   0.38268343236508977f)

template <int P, bool INV>
FFT_DEV void fft_fused(FFT_LAS f32x2* x, const FFT_LAS f32x2* T0, const FFT_LAS f32x2* T1, int tid) {
    constexpr int lgL = 14 - 2 * P, lgq = lgL - 2, lgq2 = lgL - 4, q = 1 << lgq, q2 = 1 << lgq2;
#pragma unroll
    for (int i = 0; i < 2; ++i) {
        int tl = tid; FFT_LAUNDER(tl);
        const int g = tl + 512 * i, jp = g & (q2 - 1), blk = g >> lgq2, base = (blk << lgL) + jp;
        const int k = jp << (2 * P);
        const f32x2 t = cmul(T1[k >> 7], T0[k & 127]);
        const f32x2 t2 = cmul(t, t), t3 = cmul(t2, t), t4 = cmul(t2, t2), t8 = cmul(t4, t4), t12 = cmul(t8, t4);
        f32x2 v[4][4];
        int a_hi, a_lo;
        if constexpr (P == 0) { a_lo = fswz(base); a_hi = 0; }
        else if constexpr (P == 2) { const int j5 = (jp >> 5) & 1; a_lo = (jp & 31) ^ j5; a_hi = (blk << lgL) + (j5 << 5); }
        else { const int sb = ((blk & 1) * 6) | (((blk >> 1) & 3) << 3); a_lo = jp ^ sb; a_hi = blk << lgL; }
#define FFT_SLOT(m, mp) (P == 0 ? a_lo + ((m) * 4 + (mp)) * 1024 : P == 2 ? a_hi + (m) * 256 + (mp) * 64 + (a_lo ^ ((((mp) & 1) * 6) | ((((mp) >> 1) | (((m) & 1) << 1)) << 3))) : a_hi + ((m) >> 1) * 32 + (a_lo ^ (((m) >> 1) | (((m) & 1) << 4) | ((mp) << 2))))
#pragma unroll
        for (int m = 0; m < 4; ++m)
#pragma unroll
            for (int mp = 0; mp < 4; ++mp) v[m][mp] = x[FFT_SLOT(m, mp)];
        if (!INV) {
#pragma unroll
            for (int mp = 0; mp < 4; ++mp) {
                f4_fwd(v[0][mp], v[1][mp], v[2][mp], v[3][mp]);
                const f32x2 w1 = cmul(t, (f32x2){FFT_C16R(mp), FFT_C16I(mp)}), w2 = cmul(t2, (f32x2){FFT_C16R(2 * mp), FFT_C16I(2 * mp)}), w3 = cmul(t3, (f32x2){FFT_C16R(3 * mp), FFT_C16I(3 * mp)});
                v[1][mp] = cmul(v[1][mp], w1); v[2][mp] = cmul(v[2][mp], w2); v[3][mp] = cmul(v[3][mp], w3);
            }
#pragma unroll
            for (int m = 0; m < 4; ++m) {
                f4_fwd(v[m][0], v[m][1], v[m][2], v[m][3]);
                v[m][1] = cmul(v[m][1], t4); v[m][2] = cmul(v[m][2], t8); v[m][3] = cmul(v[m][3], t12);
            }
        } else {
#pragma unroll
            for (int m = 0; m < 4; ++m) {
                v[m][1] = cmulc(v[m][1], t4); v[m][2] = cmulc(v[m][2], t8); v[m][3] = cmulc(v[m][3], t12);
                f4_inv(v[m][0], v[m][1], v[m][2], v[m][3]);
            }
#pragma unroll
            for (int mp = 0; mp < 4; ++mp) {
                const f32x2 w1 = cmul(t, (f32x2){FFT_C16R(mp), FFT_C16I(mp)}), w2 = cmul(t2, (f32x2){FFT_C16R(2 * mp), FFT_C16I(2 * mp)}), w3 = cmul(t3, (f32x2){FFT_C16R(3 * mp), FFT_C16I(3 * mp)});
                v[1][mp] = cmulc(v[1][mp], w1); v[2][mp] = cmulc(v[2][mp], w2); v[3][mp] = cmulc(v[3][mp], w3);
                f4_inv(v[0][mp], v[1][mp], v[2][mp], v[3][mp]);
            }
        }
#pragma unroll
        for (int m = 0; m < 4; ++m)
#pragma unroll
            for (int mp = 0; mp < 4; ++mp) x[FFT_SLOT(m, mp)] = v[m][mp];
#undef FFT_SLOT
    }
}
template <bool INV>
FFT_DEV void fft_last(FFT_LAS f32x2* x, int tid) {
#pragma unroll 2
    for (int i = 0; i < 8; ++i) {
        int tl = tid; FFT_LAUNDER(tl);
        const int b = (tl + 512 * i) * 4;
        const int a0 = fswz(b), a1 = a0 ^ 1, a2 = a0 ^ 2, a3 = a0 ^ 3;
        f32x2 v0 = x[a0], v1 = x[a1], v2 = x[a2], v3 = x[a3];
        if (!INV) f4_fwd(v0, v1, v2, v3); else f4_inv(v0, v1, v2, v3);
        x[a0] = v0; x[a1] = v1; x[a2] = v2; x[a3] = v3;
    }
}
FFT_DEV void fft_fwd(FFT_LAS f32x2* x, const FFT_LAS f32x2* T0, const FFT_LAS f32x2* T1, int tid) {
    fft_fused<0, false>(x, T0, T1, tid); FFT_SYNC();
    fft_fused<2, false>(x, T0, T1, tid); FFT_SYNC();
    fft_fused<4, false>(x, T0, T1, tid); FFT_SYNC();
    fft_last<false>(x, tid); FFT_SYNC();
}
FFT_DEV void fft_inv(FFT_LAS f32x2* x, const FFT_LAS f32x2* T0, const FFT_LAS f32x2* T1, int tid) {
    fft_last<true>(x, tid); FFT_SYNC();
    fft_fused<4, true>(x, T0, T1, tid); FFT_SYNC();
    fft_fused<2, true>(x, T0, T1, tid); FFT_SYNC();
    fft_fused<0, true>(x, T0, T1, tid); FFT_SYNC();
}
__device__ __forceinline__ void conv8(const bf16* row, int n0, float w0, float w1, float w2, float cb, float (&out)[8]) {
    const v4u w = *(const v4u*)(row + n0);
    float v[10];
    v[1] = bflo(w.x); v[2] = bfhi(w.x); v[3] = bflo(w.y); v[4] = bfhi(w.y); v[5] = bflo(w.z); v[6] = bfhi(w.z); v[7] = bflo(w.w); v[8] = bfhi(w.w);
    v[0] = (n0 > 0) ? __uint_as_float((unsigned)row[n0 - 1] << 16) : 0.f;
    v[9] = (n0 + 8 < SEQ) ? __uint_as_float((unsigned)row[n0 + 8] << 16) : 0.f;
#pragma unroll
    for (int e = 0; e < 8; ++e) out[e] = w0 * v[e] + w1 * v[e + 1] + w2 * v[e + 2] + cb;
}
__device__ __forceinline__ void hyena_phase(LAS unsigned char* lds, int wave) {
    LANE_TID;
    unsigned char* ws = KWS;
    LAS f32x2* x = (LAS f32x2*)lds;
    LAS f32x2* T0 = (LAS f32x2*)(lds + RING_BYTES);
    LAS f32x2* T1 = T0 + 128;
    if (tid < 160) { const int k = tid < 128 ? tid : (tid - 128) * 128; float s, c; sincospif(-(float)k * (1.0f / 8192.0f), &s, &c);
        if (tid < 128) T0[tid] = (f32x2){c, s}; else T1[tid - 128] = (f32x2){c, s}; }
    __syncthreads();
    const bf16* HYT = (const bf16*)(ws + WS_HYT); const bf16* FILT = (const bf16*)(ws + WS_FILT); bf16* YT = (bf16*)(ws + WS_YHYT);
    const float* cw = (const float*)KARG(7); const float* cbv = (const float*)KARG(8); const float* hb = (const float*)KARG(17);
    unsigned long long* Zs = (unsigned long long*)(ws + WS_ACT) + (size_t)blockIdx.x * 16384;
    for (int c = blockIdx.x; c < HYW; c += gridDim.x) {
        f32x2 kf[32]; f32x2 zr[16];
        const float delta = fabsf(-15.350567286626973f + (float)c * ((-3.0701134573253945f + 15.350567286626973f) / 1023.0f)); const float nd = -delta * (1.0f / 8191.0f);
        {
            const bf16* ff0 = FILT + (size_t)c * SEQ; const bf16* fb0 = FILT + (size_t)(1024 + c) * SEQ; const bf16* ff1 = FILT + (size_t)(2048 + c) * SEQ; const bf16* fb1 = FILT + (size_t)(3072 + c) * SEQ;
#pragma unroll
            for (int h = 0; h < 2; ++h) { int tq = tid; FFT_LAUNDER(tq); const int n0 = (tq + NTHR * h) * 8;
                const v4u wf0 = *(const v4u*)(ff0 + n0), wb0 = *(const v4u*)(fb0 + n0), wf1 = *(const v4u*)(ff1 + n0), wb1 = *(const v4u*)(fb1 + n0);
                const float vf0[8] = {bflo(wf0.x), bfhi(wf0.x), bflo(wf0.y), bfhi(wf0.y), bflo(wf0.z), bfhi(wf0.z), bflo(wf0.w), bfhi(wf0.w)};
                const float vb0[8] = {bflo(wb0.x), bfhi(wb0.x), bflo(wb0.y), bfhi(wb0.y), bflo(wb0.z), bfhi(wb0.z), bflo(wb0.w), bfhi(wb0.w)};
                const float vf1[8] = {bflo(wf1.x), bfhi(wf1.x), bflo(wf1.y), bfhi(wf1.y), bflo(wf1.z), bfhi(wf1.z), bflo(wf1.w), bfhi(wf1.w)};
                const float vb1[8] = {bflo(wb1.x), bfhi(wb1.x), bflo(wb1.y), bfhi(wb1.y), bflo(wb1.z), bfhi(wb1.z), bflo(wb1.w), bfhi(wb1.w)};
#pragma unroll
                for (int e = 0; e < 8; ++e) { const int n = n0 + e; const float dc = __expf(nd * (float)n); x[fswz(n)] = (f32x2){vf0[e] * dc, vf1[e] * dc};
                    if (n > 0) x[fswz(16384 - n)] = (f32x2){vb0[e] * dc, vb1[e] * dc}; } }
            if (tid == 0) x[8192] = (f32x2){0.f, 0.f};
            __syncthreads();
            if (tid == 0) { x[0].x += hb[c]; x[0].y += hb[HYW + c]; }
            __syncthreads();
            fft_fwd(x, T0, T1, tid);
#pragma unroll
            for (int i = 0; i < 32; ++i) { int tq = tid; FFT_LAUNDER(tq); const int p = tq + NTHR * i, pp = fft_partner_slot(p);
                const f32x2 u = x[p], w = x[pp];
                kf[i] = (f32x2){u.x + w.x, u.y - w.y} * (0.5f / 16384.0f);
                Zs[p] = __builtin_bit_cast(unsigned long long, u); }
            asm volatile("s_waitcnt vmcnt(0)" ::: "memory");
            __syncthreads();
        }
#pragma unroll
        for (int o = 0; o < 2; ++o) {
            if (o == 0) {
                const float w0 = cw[c], w1 = cw[3072 + c], w2 = cw[6144 + c], cb = cbv[c];
                const bf16* r0 = HYT + (size_t)c * MTOK; const bf16* r1 = r0 + SEQ;
#pragma unroll
                for (int h = 0; h < 2; ++h) { int tq = tid; FFT_LAUNDER(tq); const int n0 = (tq + NTHR * h) * 8; float u0[8], u1[8];
                    conv8(r0, n0, w0, w1, w2, cb, u0); conv8(r1, n0, w0, w1, w2, cb, u1);
#pragma unroll
                    for (int e = 0; e < 8; ++e) { x[fswz(n0 + e)] = (f32x2){u0[e], u1[e]}; x[fswz(8192 + n0 + e)] = (f32x2){0.f, 0.f}; } }
            } else {
#pragma unroll
                for (int i = 0; i < 32; ++i) { int tq = tid; FFT_LAUNDER(tq); const int p = tq + NTHR * i, pp = fft_partner_slot(p);
                    const f32x2 u = __builtin_bit_cast(f32x2, __hip_atomic_load(Zs + p, __ATOMIC_RELAXED, __HIP_MEMORY_SCOPE_AGENT));
                    const f32x2 w = __builtin_bit_cast(f32x2, __hip_atomic_load(Zs + pp, __ATOMIC_RELAXED, __HIP_MEMORY_SCOPE_AGENT));
                    kf[i] = (f32x2){u.y + w.y, w.x - u.x} * (0.5f / 16384.0f); }
#pragma unroll
                for (int h = 0; h < 2; ++h) { int tq = tid; FFT_LAUNDER(tq); const int n0 = (tq + NTHR * h) * 8;
#pragma unroll
                    for (int e = 0; e < 8; ++e) { x[fswz(n0 + e)] = zr[h * 8 + e]; x[fswz(8192 + n0 + e)] = (f32x2){0.f, 0.f}; } }
            }
            __syncthreads();
            fft_fwd(x, T0, T1, tid);
#pragma unroll
            for (int i = 0; i < 32; ++i) x[tid + NTHR * i] = cmul(x[tid + NTHR * i], kf[i]);
            __syncthreads();
            fft_inv(x, T0, T1, tid);
            if (o == 0) {
                const float w0 = cw[1024 + c], w1 = cw[3072 + 1024 + c], w2 = cw[6144 + 1024 + c], cb = cbv[1024 + c];
                const bf16* r0 = HYT + (size_t)(1024 + c) * MTOK; const bf16* r1 = r0 + SEQ;
#pragma unroll
                for (int h = 0; h < 2; ++h) { int tq = tid; FFT_LAUNDER(tq); const int n0 = (tq + NTHR * h) * 8; float g0[8], g1[8];
                    conv8(r0, n0, w0, w1, w2, cb, g0); conv8(r1, n0, w0, w1, w2, cb, g1);
#pragma unroll
                    for (int e = 0; e < 8; ++e) { const f32x2 r = x[fswz(n0 + e)]; zr[h * 8 + e] = (f32x2){g0[e] * r.x, g1[e] * r.y}; } }
                __syncthreads();
            }
        }
        {
            const float w0 = cw[2048 + c], w1 = cw[3072 + 2048 + c], w2 = cw[6144 + 2048 + c], cb = cbv[2048 + c];
            const bf16* r0 = HYT + (size_t)(2048 + c) * MTOK; const bf16* r1 = r0 + SEQ;
#pragma unroll
            for (int h = 0; h < 2; ++h) { int tq = tid; FFT_LAUNDER(tq); const int n0 = (tq + NTHR * h) * 8; float g0[8], g1[8];
                conv8(r0, n0, w0, w1, w2, cb, g0); conv8(r1, n0, w0, w1, w2, cb, g1);
                float y0[8], y1[8];
#pragma unroll
                for (int e = 0; e < 8; ++e) { const f32x2 r = x[fswz(n0 + e)]; y0[e] = g0[e] * r.x; y1[e] = g1[e] * r.y; }
                *(v4u*)(YT + (size_t)c * SEQ + n0) = (v4u){pk2(y0[0], y0[1]), pk2(y0[2], y0[3]), pk2(y0[4], y0[5]), pk2(y0[6], y0[7])};
                *(v4u*)(YT + (size_t)(HYW + c) * SEQ + n0) = (v4u){pk2(y1[0], y1[1]), pk2(y1[2], y1[3]), pk2(y1[4], y1[5]), pk2(y1[6], y1[7])}; }
            __syncthreads();
        }
    }
}

__device__ __forceinline__ void combine_phase(LAS unsigned char* lds, int wave) {
    LANE_TID;
    unsigned char* ws = KWS;
    const int gw = blockIdx.x * NWAVES + wave, NGW = gridDim.x * NWAVES;
    const float lam = __expf(wave_sum(((const float*)KARG(20))[lane] * ((const float*)KARG(21))[lane])) - __expf(wave_sum(((const float*)KARG(22))[lane] * ((const float*)KARG(23))[lane])) + 0.2f;
    const bf16* OC = (const bf16*)(ws + WS_OC); bf16* YA = (bf16*)(ws + WS_YATT);
    const float* sg = (const float*)KARG(24);
    const int h = lane >> 3, sub = lane & 7;
    float g[16];
#pragma unroll
    for (int i = 0; i < 16; ++i) g[i] = sg[sub * 16 + i] * 0.8f;
    for (int tok = gw; tok < MTOK; tok += NGW) {
        const bf16* p1 = OC + (size_t)tok * 2048 + (2 * h) * 128 + sub * 16; const bf16* p2 = p1 + 128;
        const v4u a0 = *(const v4u*)p1, a1 = *(const v4u*)(p1 + 8), b0 = *(const v4u*)p2, b1 = *(const v4u*)(p2 + 8);
        float d[16];
        const unsigned aw[8] = {a0.x, a0.y, a0.z, a0.w, a1.x, a1.y, a1.z, a1.w}, bw[8] = {b0.x, b0.y, b0.z, b0.w, b1.x, b1.y, b1.z, b1.w};
        float ss = 0.f;
#pragma unroll
        for (int i = 0; i < 8; ++i) { d[2 * i] = bflo(aw[i]) - lam * bflo(bw[i]); d[2 * i + 1] = bfhi(aw[i]) - lam * bfhi(bw[i]); ss += d[2 * i] * d[2 * i] + d[2 * i + 1] * d[2 * i + 1]; }
        ss += __shfl_xor(ss, 1); ss += __shfl_xor(ss, 2); ss += __shfl_xor(ss, 4);
        const float rinv = rsqrtf(ss * (1.0f / 128.0f) + 1e-6f);
        unsigned ow[8];
#pragma unroll
        for (int i = 0; i < 8; ++i) ow[i] = pk2(d[2 * i] * rinv * g[2 * i], d[2 * i + 1] * rinv * g[2 * i + 1]);
        bf16* op = YA + (size_t)tok * 1024 + h * 128 + sub * 16;
        *(v4u*)op = (v4u){ow[0], ow[1], ow[2], ow[3]}; *(v4u*)(op + 8) = (v4u){ow[4], ow[5], ow[6], ow[7]};
    }
    {
        const bf16* YT = (const bf16*)(ws + WS_YHYT); bf16* YH = (bf16*)(ws + WS_YHY);
        LAS bf16* t = (LAS bf16*)(lds + wave * 9216);
        for (int it = gw; it < 16 * 256; it += NGW) {
            const int cb = it & 15, tb = it >> 4;
            const int bidx = tb >> 7, n0 = (tb & 127) * 64;
#pragma unroll
            for (int r = 0; r < 8; ++r) { const int ch = r * 8 + (lane >> 3), tk = (lane & 7) * 8;
                const v4u w = *(const v4u*)(YT + ((size_t)(bidx * HYW + cb * 64 + ch)) * SEQ + n0 + tk);
                const unsigned ww[4] = {w.x, w.y, w.z, w.w};
#pragma unroll
                for (int e = 0; e < 4; ++e) { t[(tk + 2 * e) * 72 + ch] = (bf16)(ww[e] & 0xffffu); t[(tk + 2 * e + 1) * 72 + ch] = (bf16)(ww[e] >> 16); } }
            asm volatile("s_waitcnt lgkmcnt(0)" ::: "memory");
#pragma unroll
            for (int r = 0; r < 8; ++r) { const int tk = r * 8 + (lane >> 3), ch = (lane & 7) * 8;
                const v4u w = *(const LAS v4u*)(t + tk * 72 + ch);
                *(v4u*)(YH + (size_t)(tb * 64 + tk) * 1024 + cb * 64 + ch) = w; }
            asm volatile("s_waitcnt lgkmcnt(0)" ::: "memory");
        }
    }
}


__device__ __forceinline__ void seam_barrier(unsigned* w, unsigned G, int wave) {
    asm volatile("s_waitcnt vmcnt(0)" ::: "memory");
    __syncthreads();
    if (wave == 0) {
        if (lane_id() == 0) {
            const unsigned g = blockIdx.x & 7u, nper = (G + 7u - g) >> 3, ng = G < 8u ? G : 8u;
            __builtin_amdgcn_fence(__ATOMIC_RELEASE, "agent");
            asm volatile("s_waitcnt vmcnt(0)" ::: "memory");
            const unsigned old = __hip_atomic_fetch_add(w + 64 * (1 + g), 1u, __ATOMIC_RELAXED, __HIP_MEMORY_SCOPE_AGENT);
            if (old == nper - 1u) {
                __hip_atomic_fetch_add(w, 1u, __ATOMIC_RELAXED, __HIP_MEMORY_SCOPE_AGENT);
                while (__hip_atomic_load(w, __ATOMIC_RELAXED, __HIP_MEMORY_SCOPE_AGENT) < ng) __builtin_amdgcn_s_sleep(1);
                __hip_atomic_store(w + 64 * (9 + g), 1u, __ATOMIC_RELAXED, __HIP_MEMORY_SCOPE_AGENT);
            } else {
                while (__hip_atomic_load(w + 64 * (9 + g), __ATOMIC_RELAXED, __HIP_MEMORY_SCOPE_AGENT) == 0u) __builtin_amdgcn_s_sleep(1);
            }
            __builtin_amdgcn_fence(__ATOMIC_ACQUIRE, "agent");
            asm volatile("s_waitcnt vmcnt(0)" ::: "memory");
        }
    }
    __syncthreads();
}

__global__ void __launch_bounds__(NTHR) mega_fwd(Args a) {
    extern __shared__ __attribute__((aligned(16))) unsigned char shm[];
    cg::grid_group grid = cg::this_grid();
    LAS unsigned char* lds = (LAS unsigned char*)shm;
    const int wave = __builtin_amdgcn_readfirstlane(threadIdx.x >> 6);

    const int G = gridDim.x;
#define ws (KWS)
#define lo (KARGI(272))
#define hi (KARGI(276))
#ifndef DUP_P0
#define DUP_P0 0
#endif
#ifndef DUP_HY
#define DUP_HY 0
#endif
#ifndef DUP_ATT
#define DUP_ATT 0
#endif
#ifndef PHMASK
#define PHMASK 0x3ff
#endif
#define IN(k) (((PHMASK >> (k)) & 1) && lo <= (k) && (k) < hi)
#define SEAM(k) do { if (IN(k) && IN((k) + 1)) seam_barrier((unsigned*)(ws + WS_BAR) + 2048 * (k), (unsigned)G, wave); } while (0)
#define modp ((const float*)(ws + WS_MODP))
#define mod ((float*)(ws + WS_MOD))
#define ACT ((bf16*)(ws + WS_ACT))

    if (KARGI(272) < 0) grid.sync();
    if (IN(0)) for (int rep_ = KARGI(280); rep_ > 0; --rep_) phase0(lds, wave);
    SEAM(0);
    if (IN(1)) {
        LANE_TID;
        LAS float* fac = (LAS float*)lds; LAS float* sh = fac + 2 * DM;
        const float* b_ada = (const float*)KARG(4); const float* g = (const float*)KARG(5);
        for (int i = tid; i < 2 * DM; i += NTHR) { const int b = i >> 11, col = i & 2047;
            fac[i] = g[col] * (1.0f + mod_from_partials(modp, b_ada, b, DM + col)); sh[i] = mod_from_partials(modp, b_ada, b, col); }
        for (int i = blockIdx.x * NTHR + tid; i < 2 * NMOD; i += G * NTHR) { const int b = i / NMOD, j = i % NMOD; mod[i] = mod_from_partials(modp, b_ada, b, j); }
        __syncthreads();
        norm_rows<2>((const float*)KARG(0), ACT, ws + WS_H8, fac, sh, blockIdx.x * NWAVES + wave, G * NWAVES, lane);
        __syncthreads();
        pg8::Gemm gm{(const bf16*)(ws + WS_WTF), (const bf16*)(ws + WS_H3), 4096, 8192, 128}; pg8::StaticOrder S; S.init(4096, 8192, G, (int)blockIdx.x);
        pg8::EpiPlain E{(bf16*)(ws + WS_FILT), SEQ};
        pg8::gemm_phase<pg8::EpiPlain, pg8::StaticOrder, true, true>(lds, gm, S, E, wave);
    }
    SEAM(1);
    if (IN(2)) {
        { pg8::Gemm gm{(const bf16*)(ws + WS_WTHY), ACT, 3072, MTOK, DM}; pg8::StaticOrder S; S.init(3072, MTOK, G, (int)blockIdx.x);
          pg8::EpiPlain E{(bf16*)(ws + WS_HYT), MTOK};
          pg8::gemm_phase<pg8::EpiPlain, pg8::StaticOrder, true, true>(lds, gm, S, E, wave); }
        { pg8::Gemm gm{ACT, (const bf16*)(ws + WS_WTRE), MTOK, 3072, DM}; pg8::StaticOrder S; S.init(MTOK, 3072, G, (int)blockIdx.x);
          pg8::EpiProj E{(bf16*)(ws + WS_Q), (bf16*)(ws + WS_K), (bf16*)(ws + WS_V), (bf16*)KOUT, (const float*)(ws + WS_ROPE), (const float*)KARG(18), (const float*)KARG(19), 0};
          pg8::gemm_phase<pg8::EpiProj, pg8::StaticOrder, true, true>(lds, gm, S, E, wave); }
        { pg8::Gemm gm{(const bf16*)(ws + WS_H8), (const bf16*)(ws + WS_WTG8), MTOK, 4096, DM / 2}; pg8::StaticOrder S; S.init(MTOK, 4096, G, (int)blockIdx.x);
          pg8::EpiProj E{(bf16*)(ws + WS_Q), (bf16*)(ws + WS_K), (bf16*)(ws + WS_V), (bf16*)KOUT, (const float*)(ws + WS_ROPE), (const float*)KARG(18), (const float*)KARG(19), 12};
          pg8::gemm_phase<pg8::EpiProj, pg8::StaticOrder, true, true, 1>(lds, gm, S, E, wave); }
    }
    SEAM(2);
    if (IN(3)) {
        for (int rep_ = KARGI(292); rep_ > 0; --rep_) { hyena_phase(lds, wave); __syncthreads(); }
        __syncthreads();
        float sh_att;
        { LANE_TID; float gq = fabsf(((const float*)KARG(18))[lane]), gk = fabsf(((const float*)KARG(19))[lane]);
#pragma unroll
          for (int o_ = 1; o_ < 64; o_ <<= 1) { gq = fmaxf(gq, __shfl_xor(gq, o_)); gk = fmaxf(gk, __shfl_xor(gk, o_)); }
          const float bound = 64.0f * gq * gk * (0.125f * 1.4426950408889634f) * 1.02f; sh_att = __uint_as_float(__builtin_amdgcn_readfirstlane(__float_as_uint((bound > 64.0f) ? bound : 0.f))); }
        const int vcu = (G % 8 == 0) ? ((int)blockIdx.x % 8) * (G / 8) + (int)blockIdx.x / 8 : (int)blockIdx.x;
        for (int rep_ = KARGI(296); rep_ > 0; --rep_)
        for (int u = vcu; u < 1024; u += G) {
            const int bh = u >> 5, qb = u & 31, b = bh >> 4, qh = bh & 15;
            const bf16* Qb = (const bf16*)(ws + WS_Q) + ((size_t)b * SEQ + qb * 256) * 1024 + qh * 64;
            const bf16* Kh = (const bf16*)(ws + WS_K) + ((size_t)b * SEQ) * 1024 + qh * 64;
            const bf16* Vh = (const bf16*)(ws + WS_V) + ((size_t)b * SEQ) * 1024 + (qh >> 1) * 128;
            bf16* Ob = (bf16*)(ws + WS_OC) + ((size_t)b * SEQ + qb * 256) * 2048 + qh * 128;
            att::attn_unit(Qb, Kh, Vh, Ob, (char*)shm, wave, sh_att, (rep_ >= 2) ? 0 : 1);
        }
    }
    SEAM(3);
#ifdef PROBE_SEAMS
    for (int k_ = 9; k_ < 16; ++k_) seam_barrier((unsigned*)(ws + WS_BAR) + 2048 * k_, (unsigned)G, wave);
#endif
    if (IN(4)) combine_phase(lds, wave);
    SEAM(4);
    if (IN(5)) {
        { pg8::Gemm gm{(const bf16*)(ws + WS_YHY), (const bf16*)(ws + WS_WTPH), MTOK, DM, HYW}; pg8::StaticOrder S; S.init(MTOK, DM, G, (int)blockIdx.x);
          pg8::EpiGate1 E{(bf16*)(ws + WS_T), (const bf16*)KOUT};
          pg8::gemm_phase<pg8::EpiGate1, pg8::StaticOrder, false, true>(lds, gm, S, E, wave); }
        { pg8::Gemm gm{(const bf16*)(ws + WS_YATT), (const bf16*)(ws + WS_WTPA), MTOK, DM, HYW}; pg8::StaticOrder S; S.init(MTOK, DM, G, (int)blockIdx.x);
          pg8::EpiGate2 E{(const bf16*)(ws + WS_T), (const bf16*)KOUT, ACT};
          pg8::gemm_phase<pg8::EpiGate2, pg8::StaticOrder, false, true>(lds, gm, S, E, wave); }
    }
    SEAM(5);
    if (IN(6)) {
        pg8::Gemm gm{ACT, (const bf16*)(ws + WS_WTO), MTOK, DM, DM}; pg8::StaticOrder S; S.init(MTOK, DM, G, (int)blockIdx.x);
        pg8::EpiRes E{(const float*)KARG(0), KOUT, mod + 2 * DM, NMOD};
        pg8::gemm_phase<pg8::EpiRes, pg8::StaticOrder, false, true>(lds, gm, S, E, wave);
    }
    SEAM(6);
    if (IN(7)) {
        LANE_TID;
        LAS float* fac = (LAS float*)lds; LAS float* sh = fac + 2 * DM;
        const float* g = (const float*)KARG(28);
        for (int i = tid; i < 2 * DM; i += NTHR) { const int b = i >> 11, col = i & 2047; fac[i] = g[col] * (1.0f + mod[b * NMOD + 4 * DM + col]); sh[i] = mod[b * NMOD + 3 * DM + col]; }
        __syncthreads();
        norm_rows<1>(KOUT, ACT, nullptr, fac, sh, blockIdx.x * NWAVES + wave, G * NWAVES, lane);
        __syncthreads();
    }
    SEAM(7);
    if (IN(8)) {
        pg8::Gemm gm{ACT, (const bf16*)(ws + WS_WTGU), MTOK, 2 * FFH, DM / 2};
        pg8::StaticOrder S; S.init(MTOK, 2 * FFH, G, (int)blockIdx.x);
        pg8::EpiSwiGLU E{ws + WS_F};
        pg8::gemm_phase<pg8::EpiSwiGLU, pg8::StaticOrder, true, true, 1>(lds, gm, S, E, wave);
    }
    SEAM(8);
    if (IN(9)) {
        pg8::Gemm gm{(const bf16*)(ws + WS_F), (const bf16*)(ws + WS_WTDN), MTOK, DM, FFH / 2};
        pg8::StaticOrder S; S.init(MTOK, DM, G, (int)blockIdx.x);
        pg8::EpiRes E{KOUT, KOUT, mod + 5 * DM, NMOD};
        pg8::gemm_phase<pg8::EpiRes, pg8::StaticOrder, false, true, 1>(lds, gm, S, E, wave);
    }
#undef IN
#undef SEAM
#undef ws
#undef lo
#undef hi
#undef modp
#undef mod
#undef ACT
}

#ifndef MK_CUTS
#define MK_CUTS 0
#endif
extern "C" void kernel_launch(void* const* d_in, const int* in_sizes, int n_in, void* d_out, int out_size, void* d_ws, size_t ws_size, hipStream_t stream) {
    static int grid = 0;
    if (grid == 0) {
        if (n_in != 32 || in_sizes[0] != MTOK * DM || out_size != MTOK * DM || ws_size < WS_END) {
            fprintf(stderr, "kernel_launch: unexpected shapes: n_in %d in0 %d out %d ws %zu (need >= %zu)\n", n_in, n_in > 0 ? in_sizes[0] : -1, out_size, ws_size, (size_t)WS_END); grid = -1; return; }
        int dev = 0, cus = 0, per_cu = 0;
        hipGetDevice(&dev); hipDeviceGetAttribute(&cus, hipDeviceAttributeMultiprocessorCount, dev);
        if (hipFuncSetAttribute((const void*)mega_fwd, hipFuncAttributeMaxDynamicSharedMemorySize, LDS_BYTES) != hipSuccess) { fprintf(stderr, "kernel_launch: hipFuncSetAttribute failed\n"); grid = -1; return; }
        if (hipOccupancyMaxActiveBlocksPerMultiprocessor(&per_cu, (const void*)mega_fwd, NTHR, LDS_BYTES) != hipSuccess || per_cu < 1) { fprintf(stderr, "kernel_launch: occupancy query says %d blocks per CU\n", per_cu); per_cu = 1; }
        (void)hipGetLastError();
        grid = cus;
        if (grid % 8 != 0 || grid <= 0) { fprintf(stderr, "kernel_launch: odd CU count %d\n", grid); }
    }
    if (grid < 0) return;
    if (hipMemsetAsync((char*)d_ws + WS_BAR, 0, 131072, stream) != hipSuccess) { fprintf(stderr, "kernel_launch: hipMemsetAsync of the barrier words failed\n"); return; }
    Args a{};
    for (int i = 0; i < 32; ++i) a.in[i] = d_in[i];
    a.out = (float*)d_out; a.ws = (unsigned char*)d_ws;
    for (int i = 0; i < 12; ++i) a.rep[i] = 1;
#ifdef PROBE_REP
    a.rep[PROBE_REP] = 2;
#endif
#if MK_CUTS
    for (int p = 0; p < 10; ++p) { a.ph_lo = p; a.ph_hi = p + 1; void* args[] = {&a};
        hipError_t e = hipLaunchCooperativeKernel((const void*)mega_fwd, dim3(grid), dim3(NTHR), args, LDS_BYTES, stream);
        if (e != hipSuccess) { fprintf(stderr, "kernel_launch: cooperative launch failed: %s\n", hipGetErrorString(e)); break; } }
#else
    a.ph_lo = 0; a.ph_hi = 10; void* args[] = {&a};
    hipError_t e = hipLaunchCooperativeKernel((const void*)mega_fwd, dim3(grid), dim3(NTHR), args, LDS_BYTES, stream);
    if (e != hipSuccess) fprintf(stderr, "kernel_launch: cooperative launch failed: %s (grid %d)\n", hipGetErrorString(e), grid);
#endif
}
```

```cpp
#include <hip/hip_runtime.h>
#include <hip/hip_cooperative_groups.h>
#include <cstdio>
#include <cstdint>
namespace cg = cooperative_groups;
namespace pg8 {
#define PG8_LAS __attribute__((address_space(3)))
typedef unsigned short bf16_t;
typedef short bf16x8 __attribute__((ext_vector_type(8)));
typedef float f32x4 __attribute__((ext_vector_type(4)));
typedef unsigned u32x4 __attribute__((ext_vector_type(4)));
constexpr int BM = 256, BK = 64, HALF = 128, HTB = HALF * BK * 2  , STAGE_BYTES = 8 * HTB, NXCD = 8, WGM = 8;

__host__ __device__ __forceinline__ int lds_byte(int r, int c) { const int st = (r >> 4) * 2 + (c >> 5), rr = r & 15, cc = c & 31, ob = rr * 64 + cc * 2; return st * 1024 + (ob ^ (((ob >> 9) & 1) << 5)); }
__host__ __device__ __forceinline__ void stage_rc(int b, int& R, int& C) { const int st = b / 1024, sb = b % 1024, swz = sb ^ (((sb >> 9) & 1) << 5); R = (st >> 1) * 16 + swz / 64; C = (st & 1) * 32 + (swz % 64) / 2; }
__host__ __device__ __forceinline__ int perm32(int rho) { const int n = rho >> 4, i = rho & 15; return 8 * (i >> 2) + 4 * n + (i & 3); }

struct Unit { int pm, pn; };
struct Gemm { const bf16_t* A; const bf16_t* Bt; int M, N, K; };

struct StaticOrder {
    int nM, nN, nwg, G, c;
    __host__ __device__ void init(int M, int N, int G_, int c_) { nM = M / BM; nN = N / BM; nwg = nM * nN; G = G_; c = c_; }
    __host__ __device__ bool next(int i, Unit& u) const {
        const long L = (long)i * G + c; if (L >= nwg) return false;
        int wgid = (int)L; { const int q = nwg / NXCD, r = nwg % NXCD, xcd = wgid % NXCD, off = wgid / NXCD; wgid = (xcd < r ? xcd * (q + 1) : r * (q + 1) + (xcd - r) * q) + off; }
        const int nig = WGM * nN, gid = wgid / nig, fm = gid * WGM, gsz = (nM - fm) < WGM ? (nM - fm) : WGM;
        u.pm = fm + ((wgid % nig) % gsz); u.pn = (wgid % nig) / gsz; return true;
    }
    __device__ __forceinline__ void a_ready(const Unit&) const {}
    __device__ __forceinline__ void done(const Unit&) const {}
};

__device__ __forceinline__ unsigned cvt_pk_bf16(float lo, float hi) { unsigned r; asm volatile("v_cvt_pk_bf16_f32 %0, %1, %2" : "=v"(r) : "v"(lo), "v"(hi)); return r; }
#define PG8_F8_SCALES 0x7D79
template <int OFF> __device__ __forceinline__ void pg8_glds16(const char* gbase, unsigned voff, unsigned lds_w) { unsigned keep;
    asm volatile("s_mov_b32 %0, m0\n\ts_add_u32 m0, %3, %4\n\ts_nop 0\n\tglobal_load_lds_dwordx4 %1, %2\n\ts_mov_b32 m0, %0" : "=&s"(keep) : "v"(voff), "s"(gbase), "s"(lds_w), "i"(OFF) : "memory", "scc"); }
typedef short pg8_bf16x16 __attribute__((ext_vector_type(16))); typedef int pg8_i32x8 __attribute__((ext_vector_type(8))); typedef int pg8_i32x4 __attribute__((ext_vector_type(4)));
__device__ __forceinline__ pg8_i32x8 pg8_cat(bf16x8 lo, bf16x8 hi) { const pg8_i32x4 a = __builtin_bit_cast(pg8_i32x4, lo), b = __builtin_bit_cast(pg8_i32x4, hi); return __builtin_shufflevector(a, b, 0, 1, 2, 3, 4, 5, 6, 7); }
__device__ __forceinline__ void pg8_mfma_f8(f32x4& c, const pg8_i32x8 a, const pg8_i32x8 b, const int sc) {
    asm volatile("v_mfma_scale_f32_16x16x128_f8f6f4 %0, %1, %2, %0, %3, %3 op_sel:[0,1,0] op_sel_hi:[0,0,0]" : "+v"(c) : "v"(a), "v"(b), "v"(sc)); }
template <class Epi, class Sched, bool ALIGN_EPI = false, bool SP2 = false, int FP8 = 0>
__device__ __forceinline__ void gemm_phase(PG8_LAS unsigned char* lds, const Gemm g, const Sched& S, const Epi& E, const int wid) {
    int lane_; asm volatile("v_mbcnt_lo_u32_b32 %0, -1, 0\n\tv_mbcnt_hi_u32_b32 %0, -1, %0" : "=v"(lane_)); const int lane = lane_, tid = wid * 64 + lane, wr = wid >> 2, wc = wid & 3, fr = lane & 15, fq = lane >> 4;
    const int K = g.K, nt = K / BK;
    int f8scales = PG8_F8_SCALES; asm volatile("" : "+v"(f8scales));
    unsigned voffA[2], voffB[2];
#pragma unroll
    for (int i = 0; i < 2; ++i) { int R, C; stage_rc(tid * 16 + i * 8192, R, C); const int Rb = Epi::PERM ? ((R & ~31) + perm32(R & 31)) : R;
        voffA[i] = (unsigned)(R * K + C) * 2u; voffB[i] = (unsigned)(Rb * K + C) * 2u; }
    const size_t kstep = (size_t)(BK * 2);
    const size_t hstep = (size_t)HALF * K * 2;
    const size_t tstep = 2 * hstep;
    const unsigned ldsw = (unsigned)wid * 1024u;
    const unsigned lds_w32 = (unsigned)__builtin_amdgcn_readfirstlane((int)((unsigned)(uintptr_t)lds + ldsw));
    const int aoff = lds_byte(wr * 64 + fr, fq * 8), boff = lds_byte(wc * 32 + fr, fq * 8);
#define PG8_SA(b, h) (((b) * 2 + (h)) * HTB)
#define PG8_SB(b, h) ((4 + (b) * 2 + (h)) * HTB)
#define PG8_STAGE(bufoff, gbase, voff) do { pg8_glds16<(bufoff)>((const char*)(gbase), (voff)[0], lds_w32); pg8_glds16<(bufoff) + 8192>((const char*)(gbase), (voff)[1], lds_w32); } while (0)
#define PG8_LDA(dst, b, h) do { _Pragma("unroll") for (int m = 0; m < 4; ++m) { const bf16x8 l_ = *(const PG8_LAS bf16x8*)(lds + PG8_SA(b, h) + aoff + m * 2048), h_ = *(const PG8_LAS bf16x8*)(lds + PG8_SA(b, h) + aoff + m * 2048 + 1024); \
        dst[m] = __builtin_shufflevector(l_, h_, 0, 1, 2, 3, 4, 5, 6, 7, 8, 9, 10, 11, 12, 13, 14, 15); } } while (0)
#define PG8_LDB(dst, b, h) do { _Pragma("unroll") for (int n = 0; n < 2; ++n) { const bf16x8 l_ = *(const PG8_LAS bf16x8*)(lds + PG8_SB(b, h) + boff + n * 2048), h_ = *(const PG8_LAS bf16x8*)(lds + PG8_SB(b, h) + boff + n * 2048 + 1024); \
        dst[n] = __builtin_shufflevector(l_, h_, 0, 1, 2, 3, 4, 5, 6, 7, 8, 9, 10, 11, 12, 13, 14, 15); } } while (0)
#define PG8_LO(v) __builtin_shufflevector(v, v, 0, 1, 2, 3, 4, 5, 6, 7)
#define PG8_HI(v) __builtin_shufflevector(v, v, 8, 9, 10, 11, 12, 13, 14, 15)
#define PG8_MMA(ai, bj, At, Bt) do { __builtin_amdgcn_s_setprio(1); \
        if constexpr (FP8 != 0) {   \
            _Pragma("unroll") for (int m = 0; m < 4; ++m) _Pragma("unroll") for (int n = 0; n < 2; ++n) \
                { if constexpr (FP8 == 2) acc[ai][bj][m][n] = __builtin_amdgcn_mfma_scale_f32_16x16x128_f8f6f4(__builtin_bit_cast(pg8_i32x8, Bt[n]), __builtin_bit_cast(pg8_i32x8, At[m]), acc[ai][bj][m][n], 0, 0, 0, PG8_F8_SCALES, 1, PG8_F8_SCALES); \
                  else pg8_mfma_f8(acc[ai][bj][m][n], __builtin_bit_cast(pg8_i32x8, Bt[n]), __builtin_bit_cast(pg8_i32x8, At[m]), f8scales); } \
        } else { \
            _Pragma("unroll") for (int m = 0; m < 4; ++m) _Pragma("unroll") for (int n = 0; n < 2; ++n) { \
                acc[ai][bj][m][n] = __builtin_amdgcn_mfma_f32_16x16x32_bf16(PG8_LO(Bt[n]), PG8_LO(At[m]), acc[ai][bj][m][n], 0, 0, 0); \
                acc[ai][bj][m][n] = __builtin_amdgcn_mfma_f32_16x16x32_bf16(PG8_HI(Bt[n]), PG8_HI(At[m]), acc[ai][bj][m][n], 0, 0, 0); } } \
        __builtin_amdgcn_s_setprio(0); } while (0)
#define PG8_WAIT_V(n) asm volatile("s_waitcnt vmcnt(" #n ")" ::: "memory")
#define PG8_WAIT_L(n) asm volatile("s_waitcnt lgkmcnt(" #n ")" ::: "memory")
#define PG8_BAR __builtin_amdgcn_s_barrier()
#define PG8_SCHED __builtin_amdgcn_sched_barrier(0)
    Unit cur, nxt; int ui = 0;
    if (!S.next(0, cur)) return;
    f32x4 acc[2][2][4][2];
#pragma unroll
    for (int a = 0; a < 2; ++a)
#pragma unroll
        for (int b = 0; b < 2; ++b)
#pragma unroll
            for (int m = 0; m < 4; ++m)
#pragma unroll
                for (int n = 0; n < 2; ++n) acc[a][b][m][n] = (f32x4){0.f, 0.f, 0.f, 0.f};
    pg8_bf16x16 At[4], B0[2], B1[2];
    const char* cA = (const char*)g.A + (size_t)cur.pm * tstep; const char* cB = (const char*)g.Bt + (size_t)cur.pn * tstep;
    S.a_ready(cur);
    if constexpr (SP2) {
        PG8_STAGE(PG8_SB(0, 0), cB, voffB); PG8_STAGE(PG8_SB(0, 1), cB + hstep, voffB); PG8_STAGE(PG8_SA(0, 0), cA, voffA); PG8_STAGE(PG8_SA(0, 1), cA + hstep, voffA);
        if (wr == 1) PG8_BAR;
        PG8_WAIT_V(2); PG8_BAR;
        PG8_STAGE(PG8_SB(1, 0), cB + kstep, voffB); PG8_STAGE(PG8_SA(1, 0), cA + kstep, voffA); PG8_STAGE(PG8_SB(1, 1), cB + hstep + kstep, voffB);
        PG8_WAIT_V(6); PG8_BAR;
    } else {
        PG8_STAGE(PG8_SB(0, 0), cB, voffB); PG8_STAGE(PG8_SA(0, 0), cA, voffA); PG8_STAGE(PG8_SB(0, 1), cB + hstep, voffB); PG8_STAGE(PG8_SA(0, 1), cA + hstep, voffA);
        if (wr == 1) PG8_BAR;
        PG8_WAIT_V(4); PG8_BAR;
        PG8_STAGE(PG8_SB(1, 0), cB + kstep, voffB); PG8_STAGE(PG8_SA(1, 0), cA + kstep, voffA); PG8_STAGE(PG8_SB(1, 1), cB + hstep + kstep, voffB);
        PG8_WAIT_V(6); PG8_BAR;
    }
    for (;;) {
        const bool has_next = S.next(ui + 1, nxt);
        const char* nA = has_next ? (const char*)g.A + (size_t)nxt.pm * tstep : cA; const char* nB = has_next ? (const char*)g.Bt + (size_t)nxt.pn * tstep : cB;
        for (int t = 0; t < nt; t += 2) {
            const bool last = (t == nt - 2);
            const char* a1 = cA + (size_t)(t + 1) * kstep;
            const char* a2 = last ? nA : cA + (size_t)(t + 2) * kstep; const char* b2 = last ? nB : cB + (size_t)(t + 2) * kstep;
            const char* a3 = a2 + kstep; const char* b3 = b2 + kstep;
            if (last && has_next) S.a_ready(nxt);
            if constexpr (SP2) {
            PG8_LDB(B0, 0, 0); PG8_LDB(B1, 0, 1); PG8_SCHED; PG8_LDA(At, 0, 0); PG8_STAGE(PG8_SA(1, 1), a1 + hstep, voffA);
            PG8_WAIT_V(8); PG8_WAIT_L(0); PG8_BAR; PG8_MMA(0, 0, At, B0); PG8_MMA(0, 1, At, B1); PG8_BAR; PG8_SCHED;
            PG8_LDA(At, 0, 1); PG8_STAGE(PG8_SB(0, 0), b2, voffB); PG8_STAGE(PG8_SB(0, 1), b2 + hstep, voffB); PG8_STAGE(PG8_SA(0, 0), a2, voffA);
            PG8_WAIT_V(8); PG8_WAIT_L(0); PG8_BAR; PG8_MMA(1, 0, At, B0); PG8_MMA(1, 1, At, B1); PG8_BAR; PG8_SCHED;
            PG8_LDB(B0, 1, 0); PG8_LDB(B1, 1, 1); PG8_SCHED; PG8_LDA(At, 1, 0); PG8_STAGE(PG8_SA(0, 1), a2 + hstep, voffA);
            PG8_WAIT_V(8); PG8_WAIT_L(0); PG8_BAR; PG8_MMA(0, 0, At, B0); PG8_MMA(0, 1, At, B1); PG8_BAR; PG8_SCHED;
            PG8_LDA(At, 1, 1); PG8_STAGE(PG8_SB(1, 0), b3, voffB); PG8_STAGE(PG8_SB(1, 1), b3 + hstep, voffB); PG8_STAGE(PG8_SA(1, 0), a3, voffA);
            PG8_WAIT_V(8); PG8_WAIT_L(0); PG8_BAR; PG8_MMA(1, 0, At, B0); PG8_MMA(1, 1, At, B1); PG8_BAR; PG8_SCHED;
            } else {
            PG8_LDB(B0, 0, 0); PG8_SCHED; PG8_LDA(At, 0, 0); PG8_STAGE(PG8_SA(1, 1), a1 + hstep, voffA);
            PG8_WAIT_L(8); PG8_BAR; PG8_WAIT_L(0); PG8_MMA(0, 0, At, B0); PG8_BAR; PG8_SCHED;
            PG8_LDB(B1, 0, 1); PG8_STAGE(PG8_SB(0, 0), b2, voffB);
            PG8_BAR; PG8_WAIT_L(0); PG8_MMA(0, 1, At, B1); PG8_BAR;
            PG8_LDA(At, 0, 1); PG8_STAGE(PG8_SA(0, 0), a2, voffA);
            PG8_BAR; PG8_WAIT_L(0); PG8_MMA(1, 0, At, B0); PG8_BAR; PG8_SCHED;
            PG8_STAGE(PG8_SB(0, 1), b2 + hstep, voffB);
            PG8_WAIT_V(6); PG8_BAR; PG8_MMA(1, 1, At, B1); PG8_BAR;
            PG8_LDB(B0, 1, 0); PG8_SCHED; PG8_LDA(At, 1, 0); PG8_STAGE(PG8_SA(0, 1), a2 + hstep, voffA);
            PG8_WAIT_L(8); PG8_BAR; PG8_WAIT_L(0); PG8_MMA(0, 0, At, B0); PG8_BAR; PG8_SCHED;
            PG8_LDB(B1, 1, 1); PG8_STAGE(PG8_SB(1, 0), b3, voffB);
            PG8_BAR; PG8_WAIT_L(0); PG8_MMA(0, 1, At, B1); PG8_BAR;
            PG8_LDA(At, 1, 1); PG8_STAGE(PG8_SA(1, 0), a3, voffA);
            PG8_BAR; PG8_WAIT_L(0); PG8_MMA(1, 0, At, B0); PG8_BAR; PG8_SCHED;
            PG8_STAGE(PG8_SB(1, 1), b3 + hstep, voffB);
            PG8_WAIT_V(6); PG8_BAR; PG8_MMA(1, 1, At, B1); PG8_BAR;
            }
        }
        if constexpr (ALIGN_EPI) { if (wr == 0) PG8_BAR; }
        if constexpr (FP8 == 1) {
            asm volatile("s_nop 15\n\ts_nop 15\n\ts_nop 7" ::: "memory");
#pragma unroll
            for (int a_ = 0; a_ < 2; ++a_)
#pragma unroll
                for (int b_ = 0; b_ < 2; ++b_)
                    asm volatile("" : "+v"(acc[a_][b_][0][0]), "+v"(acc[a_][b_][0][1]), "+v"(acc[a_][b_][1][0]), "+v"(acc[a_][b_][1][1]), "+v"(acc[a_][b_][2][0]), "+v"(acc[a_][b_][2][1]), "+v"(acc[a_][b_][3][0]), "+v"(acc[a_][b_][3][1]));
        }
        if constexpr (!Epi::AFTER_DRAIN) { E(acc, cur, wr, wc, fr, fq); S.done(cur); }
        if (!has_next) break;
#pragma unroll
        for (int a = 0; a < 2; ++a)
#pragma unroll
            for (int b = 0; b < 2; ++b)
#pragma unroll
                for (int m = 0; m < 4; ++m)
#pragma unroll
                    for (int n = 0; n < 2; ++n) acc[a][b][m][n] = (f32x4){0.f, 0.f, 0.f, 0.f};
        cur = nxt; cA = nA; cB = nB; ++ui;
        if constexpr (ALIGN_EPI) { if (wr == 1) PG8_BAR; }
    }
    PG8_WAIT_V(0);
    if constexpr (!ALIGN_EPI) { if (wr == 0) PG8_BAR; }
    PG8_BAR;
    if constexpr (Epi::AFTER_DRAIN) { E.fused(acc, cur, wr, wc, fr, fq, lds, wid, lane); S.done(cur); }
#undef PG8_SA
#undef PG8_SB
#undef PG8_STAGE
#undef PG8_LDA
#undef PG8_LDB
#undef PG8_MMA
#undef PG8_WAIT_V
#undef PG8_WAIT_L
#undef PG8_BAR
#undef PG8_SCHED
}
}

namespace pg8 {
__device__ __forceinline__ float bf_lo(unsigned w) { return __uint_as_float(w << 16); }
__device__ __forceinline__ float bf_hi(unsigned w) { return __uint_as_float(w & 0xffff0000u); }
__device__ __forceinline__ u32x4 pack8(const f32x4 v0, const f32x4 v1) { u32x4 w; w.x = cvt_pk_bf16(v0[0], v0[1]); w.y = cvt_pk_bf16(v0[2], v0[3]); w.z = cvt_pk_bf16(v1[0], v1[1]); w.w = cvt_pk_bf16(v1[2], v1[3]); return w; }
__device__ __forceinline__ float sigmoidf_(float x) { return __builtin_amdgcn_rcpf(1.0f + __expf(-x)); }

struct EpiPlain {
    static constexpr bool PERM = true, AFTER_DRAIN = false;
    bf16_t* O; int ldc;
    __device__ __forceinline__ void operator()(const f32x4 (&acc)[2][2][4][2], const Unit& u, int wr, int wc, int fr, int fq) const {
        const int row0 = u.pm * BM + wr * 64 + fr, col0 = u.pn * BM + wc * 32 + 8 * fq;
#pragma unroll
        for (int ai = 0; ai < 2; ++ai)
#pragma unroll
            for (int m = 0; m < 4; ++m) { bf16_t* rowp = O + (size_t)(row0 + ai * HALF + m * 16) * ldc + col0;
#pragma unroll
                for (int bj = 0; bj < 2; ++bj) *(u32x4*)(rowp + bj * HALF) = pack8(acc[ai][bj][m][0], acc[ai][bj][m][1]); }
    }
};

struct EpiSig {
    static constexpr bool PERM = true, AFTER_DRAIN = false;
    bf16_t* O; int ldc;
    __device__ __forceinline__ void operator()(const f32x4 (&acc)[2][2][4][2], const Unit& u, int wr, int wc, int fr, int fq) const {
        const int row0 = u.pm * BM + wr * 64 + fr, col0 = u.pn * BM + wc * 32 + 8 * fq;
#pragma unroll
        for (int ai = 0; ai < 2; ++ai)
#pragma unroll
            for (int m = 0; m < 4; ++m) { bf16_t* rowp = O + (size_t)(row0 + ai * HALF + m * 16) * ldc + col0;
#pragma unroll
                for (int bj = 0; bj < 2; ++bj) { f32x4 v0 = acc[ai][bj][m][0], v1 = acc[ai][bj][m][1];
#pragma unroll
                    for (int e = 0; e < 4; ++e) { v0[e] = sigmoidf_(v0[e]); v1[e] = sigmoidf_(v1[e]); }
                    *(u32x4*)(rowp + bj * HALF) = pack8(v0, v1); } }
    }
};

struct EpiFilt {
    static constexpr bool PERM = true, AFTER_DRAIN = false;
    bf16_t* O;
    __device__ __forceinline__ void operator()(const f32x4 (&acc)[2][2][4][2], const Unit& u, int wr, int wc, int fr, int fq) const {
        const int row0 = u.pm * BM + wr * 64 + fr, col0 = u.pn * BM + wc * 32 + 8 * fq;
        const float dmin = -15.350567286626973f, dmax = -3.0701134573253945f;
#pragma unroll
        for (int ai = 0; ai < 2; ++ai)
#pragma unroll
            for (int m = 0; m < 4; ++m) { const int row = row0 + ai * HALF + m * 16; const int c = row & 1023;
                const float delta = fabsf(dmin + (float)c * ((dmax - dmin) / 1023.0f)); const float nd = -delta * (1.0f / 8191.0f);
                bf16_t* rowp = O + (size_t)row * 8192 + col0;
#pragma unroll
                for (int bj = 0; bj < 2; ++bj) { f32x4 v0 = acc[ai][bj][m][0], v1 = acc[ai][bj][m][1]; const int t0 = col0 + bj * HALF;
#pragma unroll
                    for (int e = 0; e < 4; ++e) { v0[e] *= __expf(nd * (float)(t0 + e)); v1[e] *= __expf(nd * (float)(t0 + 4 + e)); }
                    *(u32x4*)(rowp + bj * HALF) = pack8(v0, v1); } }
    }
};

struct EpiProj {
    static constexpr bool PERM = true, AFTER_DRAIN = false;
    bf16_t *Q, *Kb, *V, *G; const float* rope; const float* qg; const float* kg; int pn_off;
    __device__ __forceinline__ void operator()(const f32x4 (&acc)[2][2][4][2], const Unit& u0, int wr, int wc, int fr, int fq) const {
        Unit u; u.pm = u0.pm; u.pn = u0.pn + pn_off;
        const int row0 = u.pm * BM + wr * 64 + fr;
        if (u.pn >= 8) {
            const bool sig = u.pn >= 12;
            bf16_t* base = sig ? G : V; const int ldc = sig ? 4096 : 1024;
            const int col0 = (sig ? (u.pn - 12) : (u.pn - 8)) * BM + wc * 32 + 8 * fq;
#pragma unroll
            for (int ai = 0; ai < 2; ++ai)
#pragma unroll
                for (int m = 0; m < 4; ++m) { bf16_t* rowp = base + (size_t)(row0 + ai * HALF + m * 16) * ldc + col0;
#pragma unroll
                    for (int bj = 0; bj < 2; ++bj) { f32x4 v0 = acc[ai][bj][m][0], v1 = acc[ai][bj][m][1];
                        if (sig) {
#pragma unroll
                            for (int e = 0; e < 4; ++e) { v0[e] = sigmoidf_(v0[e]); v1[e] = sigmoidf_(v1[e]); } }
                        *(u32x4*)(rowp + bj * HALF) = pack8(v0, v1); } }
        } else {
            const bool isq = u.pn < 4; const int pnn = isq ? u.pn : u.pn - 4;
            bf16_t* base = isq ? Q : Kb; const float* g = isq ? qg : kg; const float sc = isq ? 0.125f * 1.4426950408889634f : 1.0f;
            const int head = pnn * 4 + wc;
            f32x4 gv[2][2];
#pragma unroll
            for (int bj = 0; bj < 2; ++bj)
#pragma unroll
                for (int n = 0; n < 2; ++n) gv[bj][n] = *(const f32x4*)(g + 32 * bj + 8 * fq + 4 * n);
#pragma unroll
            for (int ai = 0; ai < 2; ++ai)
#pragma unroll
                for (int m = 0; m < 4; ++m) { const int row = row0 + ai * HALF + m * 16;
                    float ss = 0.f;
#pragma unroll
                    for (int bj = 0; bj < 2; ++bj)
#pragma unroll
                        for (int n = 0; n < 2; ++n) { const f32x4 x = acc[ai][bj][m][n]; ss += (x[0] * x[0] + x[1] * x[1]) + (x[2] * x[2] + x[3] * x[3]); }
                    ss += __shfl_xor(ss, 16); ss += __shfl_xor(ss, 32);
                    const float rinv = rsqrtf(ss * (1.0f / 64.0f) + 1e-6f);
                    f32x4 v[2][2];
#pragma unroll
                    for (int bj = 0; bj < 2; ++bj)
#pragma unroll
                        for (int n = 0; n < 2; ++n) v[bj][n] = acc[ai][bj][m][n] * rinv * gv[bj][n];
                    f32x4 pr[2];
#pragma unroll
                    for (int n = 0; n < 2; ++n)
#pragma unroll
                        for (int e = 0; e < 4; ++e) pr[n][e] = __shfl_xor(v[0][n][e], 16);
                    if (fq < 2) {
                        const float* cs = rope + (size_t)row * 16;
#pragma unroll
                        for (int n = 0; n < 2; ++n) { const f32x4 c01 = *(const f32x4*)(cs + 8 * n), c23 = *(const f32x4*)(cs + 8 * n + 4);
                            const float co[4] = {c01[0], c01[2], c23[0], c23[2]}, si[4] = {c01[1], c01[3], c23[1], c23[3]};
#pragma unroll
                            for (int e = 0; e < 4; ++e) v[0][n][e] = (fq == 0) ? (v[0][n][e] * co[e] - pr[n][e] * si[e]) : (v[0][n][e] * co[e] + pr[n][e] * si[e]); }
                    }
                    bf16_t* rowp = base + (size_t)row * 1024 + head * 64 + 8 * fq;
#pragma unroll
                    for (int bj = 0; bj < 2; ++bj) *(u32x4*)(rowp + 32 * bj) = pack8(v[bj][0] * sc, v[bj][1] * sc); }
        }
    }
};

struct EpiGate1 {
    static constexpr bool PERM = true, AFTER_DRAIN = false;
    bf16_t* T; const bf16_t* G;
    __device__ __forceinline__ void operator()(const f32x4 (&acc)[2][2][4][2], const Unit& u, int wr, int wc, int fr, int fq) const {
        const int row0 = u.pm * BM + wr * 64 + fr, col0 = u.pn * BM + wc * 32 + 8 * fq;
#pragma unroll
        for (int ai = 0; ai < 2; ++ai)
#pragma unroll
            for (int m = 0; m < 4; ++m) { const size_t row = (size_t)(row0 + ai * HALF + m * 16);
#pragma unroll
                for (int bj = 0; bj < 2; ++bj) { const u32x4 gw = *(const u32x4*)(G + row * 4096 + col0 + bj * HALF);
                    f32x4 v0 = acc[ai][bj][m][0], v1 = acc[ai][bj][m][1];
                    v0[0] *= bf_lo(gw.x); v0[1] *= bf_hi(gw.x); v0[2] *= bf_lo(gw.y); v0[3] *= bf_hi(gw.y);
                    v1[0] *= bf_lo(gw.z); v1[1] *= bf_hi(gw.z); v1[2] *= bf_lo(gw.w); v1[3] *= bf_hi(gw.w);
                    *(u32x4*)(T + row * 2048 + col0 + bj * HALF) = pack8(v0, v1); } }
    }
};
struct EpiGate2 {
    static constexpr bool PERM = true, AFTER_DRAIN = false;
    const bf16_t* T; const bf16_t* G; bf16_t* O;
    __device__ __forceinline__ void operator()(const f32x4 (&acc)[2][2][4][2], const Unit& u, int wr, int wc, int fr, int fq) const {
        const int row0 = u.pm * BM + wr * 64 + fr, col0 = u.pn * BM + wc * 32 + 8 * fq;
#pragma unroll
        for (int ai = 0; ai < 2; ++ai)
#pragma unroll
            for (int m = 0; m < 4; ++m) { const size_t row = (size_t)(row0 + ai * HALF + m * 16);
#pragma unroll
                for (int bj = 0; bj < 2; ++bj) { const u32x4 gw = *(const u32x4*)(G + row * 4096 + 2048 + col0 + bj * HALF);
                    const u32x4 tw = *(const u32x4*)(T + row * 2048 + col0 + bj * HALF);
                    f32x4 v0 = acc[ai][bj][m][0], v1 = acc[ai][bj][m][1];
                    v0[0] = v0[0] * bf_lo(gw.x) + bf_lo(tw.x); v0[1] = v0[1] * bf_hi(gw.x) + bf_hi(tw.x); v0[2] = v0[2] * bf_lo(gw.y) + bf_lo(tw.y); v0[3] = v0[3] * bf_hi(gw.y) + bf_hi(tw.y);
                    v1[0] = v1[0] * bf_lo(gw.z) + bf_lo(tw.z); v1[1] = v1[1] * bf_hi(gw.z) + bf_hi(tw.z); v1[2] = v1[2] * bf_lo(gw.w) + bf_lo(tw.w); v1[3] = v1[3] * bf_hi(gw.w) + bf_hi(tw.w);
                    *(u32x4*)(O + row * 2048 + col0 + bj * HALF) = pack8(v0, v1); } }
    }
};
struct EpiRes {
    static constexpr bool PERM = false, AFTER_DRAIN = false;
    const float* base; float* out; const float* gvec; int gstride;
    __device__ __forceinline__ void operator()(const f32x4 (&acc)[2][2][4][2], const Unit& u, int wr, int wc, int, int) const {
        int l_; asm volatile("v_mbcnt_lo_u32_b32 %0, -1, 0\n\tv_mbcnt_hi_u32_b32 %0, -1, %0" : "=v"(l_));
        const int fr = l_ & 15, fq = l_ >> 4;
        const int row0 = u.pm * BM + wr * 64 + fr, col0 = u.pn * BM + wc * 32 + 4 * fq;
        const float* gb = gvec + (size_t)((u.pm * BM) >> 13) * gstride + col0;
#pragma unroll
        for (int bj = 0; bj < 2; ++bj)
#pragma unroll
            for (int n = 0; n < 2; ++n) { const f32x4 gv = *(const f32x4*)(gb + bj * HALF + n * 16);
#pragma unroll
                for (int ai = 0; ai < 2; ++ai)
#pragma unroll
                    for (int m = 0; m < 4; ++m) { const size_t off = (size_t)(row0 + ai * HALF + m * 16) * 2048 + col0 + bj * HALF + n * 16;
                        const f32x4 bs = *(const f32x4*)(base + off);
                        *(f32x4*)(out + off) = bs + gv * acc[ai][bj][m][n]; }
                asm volatile("" ::: "memory"); }
    }
};
struct EpiSwiGLU {
    static constexpr bool PERM = true, AFTER_DRAIN = false;
    unsigned char* F;
    __device__ __forceinline__ void operator()(const f32x4 (&acc)[2][2][4][2], const Unit& u, int wr, int wc, int fr, int fq) const {
        const int row0 = u.pm * BM + wr * 64 + fr, col0 = u.pn * HALF + wc * 32 + 8 * fq;
#pragma unroll
        for (int ai = 0; ai < 2; ++ai)
#pragma unroll
            for (int m = 0; m < 4; ++m) { f32x4 v[2];
#pragma unroll
                for (int n = 0; n < 2; ++n)
#pragma unroll
                    for (int e = 0; e < 4; ++e) { const float gt = acc[ai][0][m][n][e], up = acc[ai][1][m][n][e]; v[n][e] = gt * sigmoidf_(gt) * up * 4.0f; }
                unsigned w0 = 0, w1 = 0;
                w0 = __builtin_amdgcn_cvt_pk_fp8_f32(v[0][0], v[0][1], w0, false); w0 = __builtin_amdgcn_cvt_pk_fp8_f32(v[0][2], v[0][3], w0, true);
                w1 = __builtin_amdgcn_cvt_pk_fp8_f32(v[1][0], v[1][1], w1, false); w1 = __builtin_amdgcn_cvt_pk_fp8_f32(v[1][2], v[1][3], w1, true);
                typedef unsigned u32x2_ __attribute__((ext_vector_type(2)));
                *(u32x2_*)(F + (size_t)(row0 + ai * HALF + m * 16) * 5632 + col0) = (u32x2_){w0, w1}; }
    }
};
}

namespace att {
using bf16x8 = __attribute__((ext_vector_type(8))) short;
using s16x4  = __attribute__((ext_vector_type(4))) short;
using f32x16 = __attribute__((ext_vector_type(16))) float;
using u32x4  = __attribute__((ext_vector_type(4))) unsigned;
typedef unsigned short bf16_t;
constexpr int QBLK = 32, KVBLK = 64, LDQ = 1024, LDK = 1024, LDV = 1024, LDO = 2048, SEQ = 8192;
constexpr int SHM_V = KVBLK * 128 * 2, SHM_K = KVBLK * 64 * 2;
constexpr int NBUF = 4, OFF_V = 0, OFF_K = NBUF * SHM_V, ATT_LDS = NBUF * (SHM_V + SHM_K);
#define AKSWZ(row, colB) ((row) * 128 + ((colB) ^ (((row) & 7) << 4)))
#define ASBAR() __builtin_amdgcn_sched_barrier(0)
__device__ __forceinline__ int crow(int r, int hi) { return (r & 3) + 8 * (r >> 2) + 4 * hi; }
__device__ __forceinline__ unsigned cvtpk(float lo, float hi) { unsigned r; asm volatile("v_cvt_pk_bf16_f32 %0, %1, %2" : "=v"(r) : "v"(lo), "v"(hi)); return r; }

__device__ __forceinline__ void partialSM(f32x16& p0, f32x16& p1, float sh) {
  if (sh != 0.f) {
#pragma unroll
    for (int r = 0; r < 16; ++r) { p0[r] -= sh; p1[r] -= sh; }
  }
#pragma unroll
  for (int r = 0; r < 16; ++r) p0[r] = __builtin_amdgcn_exp2f(p0[r]);
}
__device__ __forceinline__ void finishSM(f32x16& p0, f32x16& p1, bf16x8& pa0, bf16x8& pa1, bf16x8& pa2, bf16x8& pa3) {
#pragma unroll
  for (int r = 0; r < 16; ++r) p1[r] = __builtin_amdgcn_exp2f(p1[r]);
#define APK4(P, BASE, OUT) do { unsigned a0 = cvtpk(P[BASE + 0], P[BASE + 1]), a1 = cvtpk(P[BASE + 2], P[BASE + 3]);   \
    unsigned b0 = cvtpk(P[BASE + 4], P[BASE + 5]), b1 = cvtpk(P[BASE + 6], P[BASE + 7]);                              \
    auto r0 = __builtin_amdgcn_permlane32_swap(a0, b0, false, false); auto r1 = __builtin_amdgcn_permlane32_swap(a1, b1, false, false); \
    u32x4 w = {r0[0], r1[0], r0[1], r1[1]}; OUT = *reinterpret_cast<bf16x8*>(&w); } while (0)
  APK4(p0, 0, pa0); APK4(p0, 8, pa1); APK4(p1, 0, pa2); APK4(p1, 8, pa3);
#undef APK4
}
__device__ __forceinline__ void qkt(f32x16& p0, f32x16& p1, const char* Ks, const bf16x8* qr, int r32, int hi) {
  p0 = f32x16{}; p1 = f32x16{};
#pragma unroll
  for (int d0 = 0; d0 < 4; ++d0) { const int cb = (d0 * 16 + hi * 8) * 2;
    bf16x8 b0 = *reinterpret_cast<const bf16x8*>(Ks + AKSWZ(r32, cb));
    bf16x8 b1 = *reinterpret_cast<const bf16x8*>(Ks + AKSWZ(32 + r32, cb));
    p0 = __builtin_amdgcn_mfma_f32_32x32x16_bf16(b0, qr[d0], p0, 0, 0, 0);
    p1 = __builtin_amdgcn_mfma_f32_32x32x16_bf16(b1, qr[d0], p1, 0, 0, 0); }
}
__device__ __forceinline__ int v_st(int k, int c) { const int kk = (k & ~0xC) | ((k & 4) << 1) | ((k & 8) >> 1); return ((kk >> 3) * 4 + (c >> 5)) * 512 + ((kk & 7) * 32 + (c & 31)) * 2; }
__device__ __forceinline__ int v_rd_base(int lane) { return ((lane & 3) << 3) | (((lane >> 2) & 3) << 6) | (((lane >> 4) & 1) << 5) | (((lane >> 5) & 1) << 8); }
constexpr int v_rd_off(int d0, int ks, int half) { return d0 * 512 + ks * 4096 + half * 2048; }
template <int OFF> __device__ __forceinline__ s16x4 tr_read(int vb) {
  s16x4 r; asm volatile("ds_read_b64_tr_b16 %0, %1 offset:%2" : "=&v"(r) : "v"(vb), "i"(OFF) : "memory"); return r;
}
template <int KS> __device__ __forceinline__ void pv_ks(f32x16* o, f32x16& osum, int vb, bf16x8 pa) {
  const s16x4 l0 = tr_read<v_rd_off(0, KS, 0)>(vb), h0 = tr_read<v_rd_off(0, KS, 1)>(vb), l1 = tr_read<v_rd_off(1, KS, 0)>(vb), h1 = tr_read<v_rd_off(1, KS, 1)>(vb);
  const s16x4 l2 = tr_read<v_rd_off(2, KS, 0)>(vb), h2 = tr_read<v_rd_off(2, KS, 1)>(vb), l3 = tr_read<v_rd_off(3, KS, 0)>(vb), h3 = tr_read<v_rd_off(3, KS, 1)>(vb);
  const bf16x8 ones = (bf16x8){0x3F80, 0x3F80, 0x3F80, 0x3F80, 0x3F80, 0x3F80, 0x3F80, 0x3F80};
  osum = __builtin_amdgcn_mfma_f32_32x32x16_bf16(pa, ones, osum, 0, 0, 0);
  asm volatile("s_waitcnt lgkmcnt(0)" ::: "memory"); ASBAR();
#define APK(L, H) (bf16x8){L[0], L[1], L[2], L[3], H[0], H[1], H[2], H[3]}
  __builtin_amdgcn_s_setprio(1);
  o[0] = __builtin_amdgcn_mfma_f32_32x32x16_bf16(pa, APK(l0, h0), o[0], 0, 0, 0);
  o[1] = __builtin_amdgcn_mfma_f32_32x32x16_bf16(pa, APK(l1, h1), o[1], 0, 0, 0);
  o[2] = __builtin_amdgcn_mfma_f32_32x32x16_bf16(pa, APK(l2, h2), o[2], 0, 0, 0);
  o[3] = __builtin_amdgcn_mfma_f32_32x32x16_bf16(pa, APK(l3, h3), o[3], 0, 0, 0);
  __builtin_amdgcn_s_setprio(0);
#undef APK
}
__device__ __forceinline__ void pv_d0(f32x16* o, f32x16& osum, int vb, bf16x8 pa0, bf16x8 pa1, bf16x8 pa2, bf16x8 pa3) {
  pv_ks<0>(o, osum, vb, pa0); pv_ks<1>(o, osum, vb, pa1); pv_ks<2>(o, osum, vb, pa2); pv_ks<3>(o, osum, vb, pa3);
}

__device__ __forceinline__ void attn_unit(const bf16_t* __restrict__ Qb, const bf16_t* __restrict__ Kh, const bf16_t* __restrict__ Vh, bf16_t* __restrict__ Ob, char* lds, const int wid, const float sh, const int kmul) {
  int lane_; asm volatile("v_mbcnt_lo_u32_b32 %0, -1, 0\n\tv_mbcnt_hi_u32_b32 %0, -1, %0" : "=v"(lane_)); const int lane = lane_, tid = wid * 64 + lane, r32 = lane & 31, hi = lane >> 5;
  char* V_lds = lds + OFF_V; char* K_lds = lds + OFF_K;
  f32x16 o[4] = {}; f32x16 osum = {}; bf16x8 qr[4];
  const bf16_t* Qw = Qb + (long)(wid * QBLK + r32) * LDQ + hi * 8;
#pragma unroll
  for (int d0 = 0; d0 < 4; ++d0) qr[d0] = *reinterpret_cast<const bf16x8*>(Qw + d0 * 16);
  const int sr = tid >> 4, sc = (tid & 15) * 8, vst0 = v_st(sr, sc);
  const int kr = tid >> 3, kc = (tid & 7) * 8, kst = AKSWZ(kr, kc * 2);
  const int vb0 = (int)(uintptr_t)V_lds + v_rd_base(lane);
  struct { bf16x8 vs0, vs1, ks0; } sr_[2];
  const unsigned voffB = (unsigned)(sr * LDV + sc) * 2u, koffB = (unsigned)(kr * LDK + kc) * 2u;
#define ASLOAD(i, k0) do { const char* vt_ = (const char*)Vh + (size_t)((k0) * kmul) * (LDV * 2); const char* kt_ = (const char*)Kh + (size_t)((k0) * kmul) * (LDK * 2); \
    sr_[i].vs0 = *reinterpret_cast<const bf16x8*>(vt_ + voffB); sr_[i].vs1 = *reinterpret_cast<const bf16x8*>(vt_ + 32 * LDV * 2 + voffB); \
    sr_[i].ks0 = *reinterpret_cast<const bf16x8*>(kt_ + koffB); } while (0)
#define ASWRITE(b, i) do { *(bf16x8*)(V_lds + (b) * SHM_V + vst0) = sr_[i].vs0; *(bf16x8*)(V_lds + (b) * SHM_V + 8192 + vst0) = sr_[i].vs1; \
    *(bf16x8*)(K_lds + (b) * SHM_K + kst) = sr_[i].ks0; } while (0)
#define ASWAIT() asm volatile("s_waitcnt vmcnt(3)" ::: "memory")
  f32x16 pA0, pA1, pB0, pB1; bf16x8 pa0, pa1, pa2, pa3; constexpr int NT = SEQ / KVBLK;
#define ALOADSTEP(j, SL) do { if ((j) + 2 < NT) { ASWAIT(); ASWRITE(((j) + 2) & 3, SL); } if ((j) + 4 < NT) ASLOAD(SL, ((j) + 4) * KVBLK); } while (0)
#define AH1(j, X0, X1, Y0, Y1) do { ASBAR(); qkt(X0, X1, K_lds + ((j) & 3) * SHM_K, qr, r32, hi); finishSM(Y0, Y1, pa0, pa1, pa2, pa3); ASBAR(); } while (0)
#define AH2(j, X0, X1) do { pv_d0(o, osum, vb0 + (((j) - 1) & 3) * SHM_V, pa0, pa1, pa2, pa3); partialSM(X0, X1, sh); } while (0)
  ASLOAD(0, 0); ASLOAD(1, KVBLK); asm volatile("s_waitcnt vmcnt(0)" ::: "memory"); ASWRITE(0, 0); ASWRITE(1, 1);
  ASLOAD(0, 2 * KVBLK); ASLOAD(1, 3 * KVBLK);
  __syncthreads();
  if (wid < 4) {
    ALOADSTEP(0, 0); qkt(pA0, pA1, K_lds, qr, r32, hi); partialSM(pA0, pA1, sh); __syncthreads();
    for (int j = 1; j + 1 < NT; j += 2) {
      ALOADSTEP(j, 1); AH1(j, pB0, pB1, pA0, pA1); AH2(j, pB0, pB1); __syncthreads();
      ALOADSTEP(j + 1, 0); AH1(j + 1, pA0, pA1, pB0, pB1); AH2(j + 1, pA0, pA1); __syncthreads();
    }
    AH1(NT - 1, pB0, pB1, pA0, pA1); AH2(NT - 1, pB0, pB1); __syncthreads();
    finishSM(pB0, pB1, pa0, pa1, pa2, pa3); ASBAR();
  } else {
    qkt(pA0, pA1, K_lds, qr, r32, hi);
    ALOADSTEP(0, 0); partialSM(pA0, pA1, sh); AH1(1, pB0, pB1, pA0, pA1); __syncthreads();
    for (int j = 1; j + 1 < NT; j += 2) {
      ALOADSTEP(j, 1); AH2(j, pB0, pB1); AH1(j + 1, pA0, pA1, pB0, pB1); __syncthreads();
      ALOADSTEP(j + 1, 0); AH2(j + 1, pA0, pA1); AH1(j + 2, pB0, pB1, pA0, pA1); __syncthreads();
    }
    AH2(NT - 1, pB0, pB1); finishSM(pB0, pB1, pa0, pa1, pa2, pa3); ASBAR(); __syncthreads();
  }
  pv_d0(o, osum, vb0 + ((NT - 1) & 3) * SHM_V, pa0, pa1, pa2, pa3);
#undef ALOADSTEP
#undef AH1
#undef AH2
  int le_; asm volatile("v_mbcnt_lo_u32_b32 %0, -1, 0\n\tv_mbcnt_hi_u32_b32 %0, -1, %0" : "=v"(le_));
  const int r32e = le_ & 31, hie = le_ >> 5;
  bf16_t* Ow = Ob + (long)(wid * QBLK) * LDO + r32e;
#pragma unroll
  for (int r = 0; r < 16; ++r) { const int orow = crow(r, hie); const float rl = __builtin_amdgcn_rcpf(osum[r]);
#pragma unroll
    for (int d0 = 0; d0 < 4; ++d0) Ow[(long)orow * LDO + d0 * 32] = (bf16_t)(cvtpk(o[d0][r] * rl, 0.f) & 0xffffu); }
  __syncthreads();
#undef ASLOAD
#undef ASWRITE
#undef ASWAIT
}
}

#define LAS __attribute__((address_space(3)))
typedef unsigned short bf16;
typedef unsigned v4u __attribute__((ext_vector_type(4)));
typedef unsigned v2u __attribute__((ext_vector_type(2)));
typedef float f32x4 __attribute__((ext_vector_type(4)));
constexpr int NWAVES = 8, NTHR = 512;
constexpr int DM = 2048, SEQ = 8192, MTOK = 16384, HYW = 1024, FFH = 5632, NMOD = 12288, WINC = 10240;
constexpr int LDS_BYTES = 147456, RING_BYTES = 131072;
constexpr size_t MiB = 1u << 20;
constexpr size_t WS_MODP = 0;
constexpr size_t WS_MOD  = 1572864;
constexpr size_t WS_BAR  = 1835008;
constexpr size_t WS_ROPE = 2 * MiB;
constexpr size_t WS_H3   = 3 * MiB;
constexpr size_t WS_WTF  = 5 * MiB;
constexpr size_t WS_WTHY = 6 * MiB;
constexpr size_t WS_WTRE = 18 * MiB;
constexpr size_t WS_WTPH = 46 * MiB;
constexpr size_t WS_WTPA = 50 * MiB;
constexpr size_t WS_WTO  = 54 * MiB;
constexpr size_t WS_WTGU = 62 * MiB;
constexpr size_t WS_WTDN = 106 * MiB;
constexpr size_t WS_ACT  = 128 * MiB;
constexpr size_t WS_HYT  = 192 * MiB;
constexpr size_t WS_Q    = 288 * MiB, WS_K = 320 * MiB, WS_V = 352 * MiB;
constexpr size_t WS_FILT = 384 * MiB;
constexpr size_t WS_OC   = 448 * MiB;
constexpr size_t WS_WTG8 = 38 * MiB;
constexpr size_t WS_H8   = 480 * MiB;
constexpr size_t WS_YHYT = 6 * MiB;
constexpr size_t WS_YHY  = 192 * MiB, WS_YATT = 224 * MiB;
constexpr size_t WS_T    = 288 * MiB;
constexpr size_t WS_F    = 192 * MiB;
constexpr size_t WS_END  = 512 * MiB;

struct Args { const void* in[32]; float* out; unsigned char* ws; int ph_lo, ph_hi; int rep[12]; };

template <int OFF> __device__ __forceinline__ const void* karg_ptr() { unsigned long long p; asm volatile("s_load_dwordx2 %0, %1, %2\n\ts_waitcnt lgkmcnt(0)" : "=s"(p) : "s"(__builtin_amdgcn_kernarg_segment_ptr()), "i"(OFF) : "memory");
    return (const void*)(__attribute__((address_space(1))) const void*)p; }
template <int OFF> __device__ __forceinline__ int karg_int() { int v; asm volatile("s_load_dword %0, %1, %2\n\ts_waitcnt lgkmcnt(0)" : "=s"(v) : "s"(__builtin_amdgcn_kernarg_segment_ptr()), "i"(OFF) : "memory"); return v; }
__device__ __forceinline__ int lane_id() { int l; asm volatile("v_mbcnt_lo_u32_b32 %0, -1, 0\n\tv_mbcnt_hi_u32_b32 %0, -1, %0" : "=v"(l)); return l; }
#define LANE_TID const int lane = lane_id(), tid = wave * 64 + lane; (void)tid; (void)lane
#define KARG(i) (karg_ptr<8 * (i)>())
#define KOUT ((float*)karg_ptr<256>())
#define KWS ((unsigned char*)karg_ptr<264>())
#define KARGI(off) (karg_int<off>())


__device__ __forceinline__ float wave_sum(float v) {
#pragma unroll
    for (int o = 1; o < 64; o <<= 1) v += __shfl_xor(v, o);
    return v;
}
__device__ __forceinline__ unsigned f2bf(float f) { unsigned u = __builtin_bit_cast(unsigned, f); return (u + 0x7fffu + ((u >> 16) & 1u)) >> 16; }
__device__ __forceinline__ unsigned pk2(float lo, float hi) { return f2bf(lo) | (f2bf(hi) << 16); }
__device__ __forceinline__ float bflo(unsigned w) { return __uint_as_float(w << 16); }
__device__ __forceinline__ float bfhi(unsigned w) { return __uint_as_float(w & 0xffff0000u); }

template <class RowMap>
__device__ __forceinline__ void transpose_item(const float* W, int K, int N, bf16* WT, int ldk, RowMap rowmap, LAS float* scr, int item, int lane) {
    const int nblk = N / 32, kb = item / nblk, nb = item % nblk, k0 = 64 * kb, n0 = 32 * nb;
#pragma unroll 8
    for (int i = 0; i < 32; ++i) { const int kk = 2 * i + (lane >> 5); scr[kk * 33 + (lane & 31)] = W[(size_t)(k0 + kk) * N + n0 + (lane & 31)]; }
    asm volatile("s_waitcnt lgkmcnt(0)" ::: "memory");
    const int c = lane & 7;
    const int rbase = rowmap(n0);
#pragma unroll
    for (int j = 0; j < 4; ++j) { const int n = (lane >> 3) + 8 * j; const LAS float* s = scr + (8 * c) * 33 + n;
        v4u o; o.x = pk2(s[0 * 33], s[1 * 33]); o.y = pk2(s[2 * 33], s[3 * 33]); o.z = pk2(s[4 * 33], s[5 * 33]); o.w = pk2(s[6 * 33], s[7 * 33]);
        *(v4u*)(WT + (size_t)(rbase + n) * ldk + k0 + 8 * c) = o; }
    asm volatile("s_waitcnt lgkmcnt(0)" ::: "memory");
}
__device__ __forceinline__ unsigned pk4_fp8(float a, float b, float c, float d) { unsigned w = 0; w = __builtin_amdgcn_cvt_pk_fp8_f32(a, b, w, false); w = __builtin_amdgcn_cvt_pk_fp8_f32(c, d, w, true); return w; }
template <class RowMap>
__device__ __forceinline__ void transpose_item_fp8(const float* W, int K, int N, unsigned char* WT8, int ldk, RowMap rowmap, float scale, LAS float* scr, int item, int lane) {
    const int nblk = N / 32, kb = item / nblk, nb = item % nblk, k0 = 64 * kb, n0 = 32 * nb;
#pragma unroll 8
    for (int i = 0; i < 32; ++i) { const int kk = 2 * i + (lane >> 5); scr[kk * 33 + (lane & 31)] = W[(size_t)(k0 + kk) * N + n0 + (lane & 31)] * scale; }
    asm volatile("s_waitcnt lgkmcnt(0)" ::: "memory");
    const int c = lane & 7;
    const int rbase = rowmap(n0);
#pragma unroll
    for (int j = 0; j < 4; ++j) { const int n = (lane >> 3) + 8 * j; const LAS float* s = scr + (8 * c) * 33 + n;
        v2u o; o.x = pk4_fp8(s[0 * 33], s[1 * 33], s[2 * 33], s[3 * 33]); o.y = pk4_fp8(s[4 * 33], s[5 * 33], s[6 * 33], s[7 * 33]);
        *(v2u*)(WT8 + (size_t)(rbase + n) * ldk + k0 + 8 * c) = o; }
    asm volatile("s_waitcnt lgkmcnt(0)" ::: "memory");
}
struct MapId { int off; __device__ __forceinline__ int operator()(int n) const { return n + off; } };
struct MapWin {
    __device__ __forceinline__ int operator()(int n) const {
        if (n < 3072) return n;
        const int r = n - 3072, pn = r >> 8;
        if (pn >= 8) return n;
        const int fe = r & 255, wc = fe >> 6, bj = (fe >> 5) & 1, i = fe & 31;
        return 3072 + (pn << 8) + 128 * bj + 32 * wc + i;
    }
};
struct MapGU { int up; __device__ __forceinline__ int operator()(int n) const { return ((n >> 7) << 8) + 128 * up + (n & 127); } };

__device__ __forceinline__ void phase0(LAS unsigned char* lds, int wave) {
    LANE_TID;
    unsigned char* ws = KWS;
    const int G = gridDim.x, bx = blockIdx.x;
    const int gw = wave * G + bx, NGW = G * NWAVES;
    const int gt = bx * NTHR + tid, NGT = G * NTHR;
    {
        const int* pos = (const int*)KARG(2); float* rope = (float*)(ws + WS_ROPE);
        for (int idx = gt; idx < MTOK * 8; idx += NGT) {
            const int tok = idx >> 3, i = idx & 7;
            const double inv = exp2(-(double)i * 0.125 * 18.931568569324174);
            double ang = (double)pos[tok] * inv;
            ang -= 6.283185307179586476925 * rint(ang * 0.15915494309189533577);
            float s, c; sincosf((float)ang, &s, &c);
            rope[2 * idx] = c; rope[2 * idx + 1] = s;
        }
    }
    {
        LAS float* w1s = (LAS float*)lds;
        LAS float* w2s = w1s + 33 * 64;
        LAS float* w3s = w2s + 64 * 64;
        LAS float* zb  = w3s + 64 * 64 + wave * 64;
        const float* w1 = (const float*)KARG(9); const float* b1 = (const float*)KARG(10); const float* w2 = (const float*)KARG(11); const float* b2 = (const float*)KARG(12);
        const float* w3 = (const float*)KARG(13); const float* b3 = (const float*)KARG(14); const float* fr = (const float*)KARG(15);
        for (int i = tid; i < 33 * 64; i += NTHR) w1s[i] = w1[i];
        for (int i = tid; i < 64 * 64; i += NTHR) { w2s[i] = w2[i]; w3s[i] = w3[i]; }
        __syncthreads();
        const float bb1 = b1[lane], bb2 = b2[lane], bb3 = b3[lane], f0 = fr[lane], f1 = fr[64 + lane], f2 = fr[128 + lane];
        bf16* H3 = (bf16*)(ws + WS_H3);
        const int iters = (SEQ + NGW - 1) / NGW;
        for (int it = 0; it < iters; ++it) {
            const int n = gw + it * NGW; const bool act = n < SEQ;
            float z = 0.f;
            if (lane == 0) z = (float)((double)n / 8191.0);
            else if (lane < 33) { const int bi = (lane - 1) & 15; const double band = 1e-4 + (double)bi * ((15.0 - 1e-4) / 15.0);
                double ang = band * (6.283185307179586476925 * (double)n / 8192.0); ang -= 6.283185307179586476925 * rint(ang * 0.15915494309189533577);
                z = (lane < 17) ? cosf((float)ang) : -sinf((float)ang); }
            zb[lane] = z; __syncthreads();
            float acc = bb1;
#pragma unroll
            for (int i = 0; i < 33; ++i) acc += zb[i] * w1s[i * 64 + lane];
            float h = sinf(f0 * acc); __syncthreads();
            zb[lane] = h; __syncthreads();
            acc = bb2;
#pragma unroll 16
            for (int i = 0; i < 64; ++i) acc += zb[i] * w2s[i * 64 + lane];
            h = sinf(f1 * acc); __syncthreads();
            zb[lane] = h; __syncthreads();
            acc = bb3;
#pragma unroll 16
            for (int i = 0; i < 64; ++i) acc += zb[i] * w3s[i * 64 + lane];
            h = sinf(f2 * acc); __syncthreads();
            if (act) { H3[(size_t)n * 128 + lane] = (bf16)f2bf(h); H3[(size_t)n * 128 + 64 + lane] = 0; }
        }
        __syncthreads();
    }
    LAS float* scs = (LAS float*)(lds + 8 * 8448);
    { const float* c = (const float*)KARG(1);
      for (int i = tid; i < 2 * DM; i += NTHR) { const float v = c[i]; scs[i] = v / (1.0f + __expf(-v)); }
      __syncthreads(); }
    if (gw < 768) {
        const int s = gw / 48, cgp = gw % 48;
        const float* w = (const float*)KARG(3) + (size_t)(s * 128) * NMOD + cgp * 256 + lane * 4;
        f32x4 a0 = {0.f, 0.f, 0.f, 0.f}, a1 = {0.f, 0.f, 0.f, 0.f};
#pragma unroll 8
        for (int k = 0; k < 128; ++k) { const f32x4 wv = *(const f32x4*)(w + (size_t)k * NMOD); const float c0 = scs[s * 128 + k], c1 = scs[DM + s * 128 + k]; a0 += wv * c0; a1 += wv * c1; }
        float* mp = (float*)(ws + WS_MODP) + (size_t)s * 2 * NMOD + cgp * 256 + lane * 4;
        *(f32x4*)mp = a0; *(f32x4*)(mp + NMOD) = a1;
    }
    {
        LAS float* scr = (LAS float*)(lds + wave * 8448);
        constexpr int I_IN = 32 * 320, I_PH = 16 * 64, I_PA = 16 * 64, I_O = 32 * 64, I_G = 32 * 176, I_U = 32 * 176, I_D = 88 * 64, I_F = 128;
        constexpr int NIT = I_IN + I_PH + I_PA + I_O + I_G + I_U + I_D + I_F;
        const int nada = (NGW > 768) ? 768 : 0; const int per_ada = 5; const int nrest = NGW - nada;
        int it, step, cnt;
        if (gw < nada) { it = gw * per_ada; step = 1; cnt = per_ada; }
        else { it = nada * per_ada + (gw - nada); step = nrest; cnt = 0x7fffffff; }
        for (int q = 0; q < cnt && it < NIT; ++q, it += step) {
            int r = it;
            if (r < I_IN) { if ((r % 320) >= 192) transpose_item_fp8((const float*)KARG(6), DM, WINC, ws + WS_WTG8, DM, MapId{-6144}, 64.0f, scr, r, lane);
                            else transpose_item((const float*)KARG(6), DM, WINC, (bf16*)(ws + WS_WTHY), DM, MapWin{}, scr, r, lane); continue; } r -= I_IN;
            if (r < I_PH) { transpose_item((const float*)KARG(25), HYW, DM, (bf16*)(ws + WS_WTPH), HYW, MapId{0}, scr, r, lane); continue; } r -= I_PH;
            if (r < I_PA) { transpose_item((const float*)KARG(26), HYW, DM, (bf16*)(ws + WS_WTPA), HYW, MapId{0}, scr, r, lane); continue; } r -= I_PA;
            if (r < I_O)  { transpose_item((const float*)KARG(27), DM, DM, (bf16*)(ws + WS_WTO), DM, MapId{0}, scr, r, lane); continue; } r -= I_O;
            if (r < I_G)  { transpose_item_fp8((const float*)KARG(29), DM, FFH, ws + WS_WTGU, DM, MapGU{0}, 64.0f, scr, r, lane); continue; } r -= I_G;
            if (r < I_U)  { transpose_item_fp8((const float*)KARG(30), DM, FFH, ws + WS_WTGU, DM, MapGU{1}, 64.0f, scr, r, lane); continue; } r -= I_U;
            if (r < I_D)  { transpose_item_fp8((const float*)KARG(31), FFH, DM, ws + WS_WTDN, FFH, MapId{0}, 64.0f, scr, r, lane); continue; } r -= I_D;
            { transpose_item((const float*)KARG(16), 64, 4096, (bf16*)(ws + WS_WTF), 128, MapId{0}, scr, r, lane);
              const int n0 = 32 * r; bf16* wt = (bf16*)(ws + WS_WTF);
#pragma unroll
              for (int j = 0; j < 4; ++j) { const int n = (lane >> 3) + 8 * j; *(v4u*)(wt + (size_t)(n0 + n) * 128 + 64 + 8 * (lane & 7)) = (v4u){0u, 0u, 0u, 0u}; } }
        }
    }
    __syncthreads();
}

template <int FP8OUT>
__device__ __forceinline__ void norm_rows(const float* X, void* Ov, void* Ov8, LAS float* fac, LAS float* sh, int gw, int NGW, int lane) {
    for (int m = gw; m < MTOK; m += NGW) {
        const f32x4* xr = (const f32x4*)(X + (size_t)m * DM) + lane;
        f32x4 v[8]; float s = 0.f;
#pragma unroll
        for (int j = 0; j < 8; ++j) { v[j] = xr[64 * j]; s += (v[j].x * v[j].x + v[j].y * v[j].y) + (v[j].z * v[j].z + v[j].w * v[j].w); }
        const float rinv = rsqrtf(wave_sum(s) * (1.0f / DM) + 1e-6f);
        const int b = m >> 13;
        const LAS f32x4* fp = (const LAS f32x4*)(fac + b * DM) + lane; const LAS f32x4* sp = (const LAS f32x4*)(sh + b * DM) + lane;
        if constexpr (FP8OUT != 0) {
            unsigned* o4 = (unsigned*)((unsigned char*)(FP8OUT == 2 ? Ov8 : Ov) + (size_t)m * DM) + lane;
#pragma unroll
            for (int j = 0; j < 8; ++j) { const f32x4 f = fp[64 * j], t = sp[64 * j]; const f32x4 y = (v[j] * rinv * f + t) * 4.0f; o4[64 * j] = pk4_fp8(y.x, y.y, y.z, y.w); }
        }
        if constexpr (FP8OUT != 1) {
        v2u* o8 = (v2u*)((bf16*)Ov + (size_t)m * DM) + lane;
#pragma unroll
        for (int j = 0; j < 8; ++j) { const f32x4 f = fp[64 * j], t = sp[64 * j]; const f32x4 y = v[j] * rinv * f + t;
            v2u w; w.x = pk2(y.x, y.y); w.y = pk2(y.z, y.w); o8[64 * j] = w; }
        }
    }
}
__device__ __forceinline__ float mod_from_partials(const float* modp, const float* b_ada, int b, int j) {
    float s = b_ada[j];
#pragma unroll
    for (int k = 0; k < 16; ++k) s += modp[(size_t)(k * 2 + b) * NMOD + j];
    return s;
}

#define FFT_DEV __device__ __forceinline__
#define FFT_LAS LAS
#define FFT_SYNC() __syncthreads()
#define FFT_LAUNDER(x) asm volatile("" : "+v"(x))

typedef float f32x2 __attribute__((ext_vector_type(2)));
FFT_DEV int fswz(int e) { return e ^ (((e >> 5) & 1) | (((e >> 6) & 1) * 6) | (((e >> 7) & 3) << 3)); }
FFT_DEV f32x2 cmul(f32x2 a, f32x2 b) { return (f32x2){a.x * b.x - a.y * b.y, a.x * b.y + a.y * b.x}; }
FFT_DEV f32x2 cmulc(f32x2 a, f32x2 b) { return (f32x2){a.x * b.x + a.y * b.y, a.y * b.x - a.x * b.y}; }
FFT_DEV void f4_fwd(f32x2& a0, f32x2& a1, f32x2& a2, f32x2& a3) {
    const f32x2 t0 = a0 + a2, t1 = a0 - a2, t2 = a1 + a3, d = a1 - a3, t3 = (f32x2){d.y, -d.x};
    a0 = t0 + t2; a1 = t1 + t3; a2 = t0 - t2; a3 = t1 - t3;
}
FFT_DEV void f4_inv(f32x2& a0, f32x2& a1, f32x2& a2, f32x2& a3) {
    const f32x2 t0 = a0 + a2, t1 = a0 - a2, t2 = a1 + a3, d = a1 - a3, t3 = (f32x2){-d.y, d.x};
    a0 = t0 + t2; a1 = t1 + t3; a2 = t0 - t2; a3 = t1 - t3;
}
FFT_DEV int fft_rev4(int e) { const unsigned r = __builtin_bitreverse32((unsigned)e) >> 18; return (int)(((r & 0x1555u) << 1) | ((r >> 1) & 0x1555u)); }
FFT_DEV int fft_partner_slot(int p) { const int f = fft_rev4(fswz(p)); return fswz(fft_rev4((16384 - f) & 16383)); }
#define FFT_C16R(k) ((k) == 0 ? 1.0f : (k) == 1 ? 0.92387953251128674f : (k) == 2 ? 0.70710678118654752f : (k) == 3 ? 0.38268343236508977f : (k) == 4 ? 0.0f : (k) == 6 ? -0.70710678118654752f :   -0.92387953251128674f)
#define FFT_C16I(k) ((k) == 0 ? 0.0f : (k) == 1 ? -0.38268343236508977f : (k) == 2 ? -0.70710678118654752f : (k) == 3 ? -0.92387953251128674f : (k) == 4 ? -1.0f : (k) == 6 ? -0.70710678118654752f :   0.38268343236508977f)

template <int P, bool INV>
FFT_DEV void fft_fused(FFT_LAS f32x2* x, const FFT_LAS f32x2* T0, const FFT_LAS f32x2* T1, int tid) {
    constexpr int lgL = 14 - 2 * P, lgq = lgL - 2, lgq2 = lgL - 4, q = 1 << lgq, q2 = 1 << lgq2;
#pragma unroll
    for (int i = 0; i < 2; ++i) {
        int tl = tid; FFT_LAUNDER(tl);
        const int g = tl + 512 * i, jp = g & (q2 - 1), blk = g >> lgq2, base = (blk << lgL) + jp;
        const int k = jp << (2 * P);
        const f32x2 t = cmul(T1[k >> 7], T0[k & 127]);
        const f32x2 t2 = cmul(t, t), t3 = cmul(t2, t), t4 = cmul(t2, t2), t8 = cmul(t4, t4), t12 = cmul(t8, t4);
        f32x2 v[4][4];
        int a_hi, a_lo;
        if constexpr (P == 0) { a_lo = fswz(base); a_hi = 0; }
        else if constexpr (P == 2) { const int j5 = (jp >> 5) & 1; a_lo = (jp & 31) ^ j5; a_hi = (blk << lgL) + (j5 << 5); }
        else { const int sb = ((blk & 1) * 6) | (((blk >> 1) & 3) << 3); a_lo = jp ^ sb; a_hi = blk << lgL; }
#define FFT_SLOT(m, mp) (P == 0 ? a_lo + ((m) * 4 + (mp)) * 1024 : P == 2 ? a_hi + (m) * 256 + (mp) * 64 + (a_lo ^ ((((mp) & 1) * 6) | ((((mp) >> 1) | (((m) & 1) << 1)) << 3))) : a_hi + ((m) >> 1) * 32 + (a_lo ^ (((m) >> 1) | (((m) & 1) << 4) | ((mp) << 2))))
#pragma unroll
        for (int m = 0; m < 4; ++m)
#pragma unroll
            for (int mp = 0; mp < 4; ++mp) v[m][mp] = x[FFT_SLOT(m, mp)];
        if (!INV) {
#pragma unroll
            for (int mp = 0; mp < 4; ++mp) {
                f4_fwd(v[0][mp], v[1][mp], v[2][mp], v[3][mp]);
                const f32x2 w1 = cmul(t, (f32x2){FFT_C16R(mp), FFT_C16I(mp)}), w2 = cmul(t2, (f32x2){FFT_C16R(2 * mp), FFT_C16I(2 * mp)}), w3 = cmul(t3, (f32x2){FFT_C16R(3 * mp), FFT_C16I(3 * mp)});
                v[1][mp] = cmul(v[1][mp], w1); v[2][mp] = cmul(v[2][mp], w2); v[3][mp] = cmul(v[3][mp], w3);
            }
#pragma unroll
            for (int m = 0; m < 4; ++m) {
                f4_fwd(v[m][0], v[m][1], v[m][2], v[m][3]);
                v[m][1] = cmul(v[m][1], t4); v[m][2] = cmul(v[m][2], t8); v[m][3] = cmul(v[m][3], t12);
            }
        } else {
#pragma unroll
            for (int m = 0; m < 4; ++m) {
                v[m][1] = cmulc(v[m][1], t4); v[m][2] = cmulc(v[m][2], t8); v[m][3] = cmulc(v[m][3], t12);
                f4_inv(v[m][0], v[m][1], v[m][2], v[m][3]);
            }
#pragma unroll
            for (int mp = 0; mp < 4; ++mp) {
                const f32x2 w1 = cmul(t, (f32x2){FFT_C16R(mp), FFT_C16I(mp)}), w2 = cmul(t2, (f32x2){FFT_C16R(2 * mp), FFT_C16I(2 * mp)}), w3 = cmul(t3, (f32x2){FFT_C16R(3 * mp), FFT_C16I(3 * mp)});
                v[1][mp] = cmulc(v[1][mp], w1); v[2][mp] = cmulc(v[2][mp], w2); v[3][mp] = cmulc(v[3][mp], w3);
                f4_inv(v[0][mp], v[1][mp], v[2][mp], v[3][mp]);
            }
        }
#pragma unroll
        for (int m = 0; m < 4; ++m)
#pragma unroll
            for (int mp = 0; mp < 4; ++mp) x[FFT_SLOT(m, mp)] = v[m][mp];
#undef FFT_SLOT
    }
}
template <bool INV>
FFT_DEV void fft_last(FFT_LAS f32x2* x, int tid) {
#pragma unroll 2
    for (int i = 0; i < 8; ++i) {
        int tl = tid; FFT_LAUNDER(tl);
        const int b = (tl + 512 * i) * 4;
        const int a0 = fswz(b), a1 = a0 ^ 1, a2 = a0 ^ 2, a3 = a0 ^ 3;
        f32x2 v0 = x[a0], v1 = x[a1], v2 = x[a2], v3 = x[a3];
        if (!INV) f4_fwd(v0, v1, v2, v3); else f4_inv(v0, v1, v2, v3);
        x[a0] = v0; x[a1] = v1; x[a2] = v2; x[a3] = v3;
    }
}
FFT_DEV void fft_fwd(FFT_LAS f32x2* x, const FFT_LAS f32x2* T0, const FFT_LAS f32x2* T1, int tid) {
    fft_fused<0, false>(x, T0, T1, tid); FFT_SYNC();
    fft_fused<2, false>(x, T0, T1, tid); FFT_SYNC();
    fft_fused<4, false>(x, T0, T1, tid); FFT_SYNC();
    fft_last<false>(x, tid); FFT_SYNC();
}
FFT_DEV void fft_inv(FFT_LAS f32x2* x, const FFT_LAS f32x2* T0, const FFT_LAS f32x2* T1, int tid) {
    fft_last<true>(x, tid); FFT_SYNC();
    fft_fused<4, true>(x, T0, T1, tid); FFT_SYNC();
    fft_fused<2, true>(x, T0, T1, tid); FFT_SYNC();
    fft_fused<0, true>(x, T0, T1, tid); FFT_SYNC();
}
__device__ __forceinline__ void conv8(const bf16* row, int n0, float w0, float w1, float w2, float cb, float (&out)[8]) {
    const v4u w = *(const v4u*)(row + n0);
    float v[10];
    v[1] = bflo(w.x); v[2] = bfhi(w.x); v[3] = bflo(w.y); v[4] = bfhi(w.y); v[5] = bflo(w.z); v[6] = bfhi(w.z); v[7] = bflo(w.w); v[8] = bfhi(w.w);
    v[0] = (n0 > 0) ? __uint_as_float((unsigned)row[n0 - 1] << 16) : 0.f;
    v[9] = (n0 + 8 < SEQ) ? __uint_as_float((unsigned)row[n0 + 8] << 16) : 0.f;
#pragma unroll
    for (int e = 0; e < 8; ++e) out[e] = w0 * v[e] + w1 * v[e + 1] + w2 * v[e + 2] + cb;
}
__device__ __forceinline__ void hyena_phase(LAS unsigned char* lds, int wave) {
    LANE_TID;
    unsigned char* ws = KWS;
    LAS f32x2* x = (LAS f32x2*)lds;
    LAS f32x2* T0 = (LAS f32x2*)(lds + RING_BYTES);
    LAS f32x2* T1 = T0 + 128;
    if (tid < 160) { const int k = tid < 128 ? tid : (tid - 128) * 128; float s, c; sincospif(-(float)k * (1.0f / 8192.0f), &s, &c);
        if (tid < 128) T0[tid] = (f32x2){c, s}; else T1[tid - 128] = (f32x2){c, s}; }
    __syncthreads();
    const bf16* HYT = (const bf16*)(ws + WS_HYT); const bf16* FILT = (const bf16*)(ws + WS_FILT); bf16* YT = (bf16*)(ws + WS_YHYT);
    const float* cw = (const float*)KARG(7); const float* cbv = (const float*)KARG(8); const float* hb = (const float*)KARG(17);
    unsigned long long* Zs = (unsigned long long*)(ws + WS_ACT) + (size_t)blockIdx.x * 16384;
    for (int c = blockIdx.x; c < HYW; c += gridDim.x) {
        f32x2 kf[32]; f32x2 zr[16];
        const float delta = fabsf(-15.350567286626973f + (float)c * ((-3.0701134573253945f + 15.350567286626973f) / 1023.0f)); const float nd = -delta * (1.0f / 8191.0f);
        {
            const bf16* ff0 = FILT + (size_t)c * SEQ; const bf16* fb0 = FILT + (size_t)(1024 + c) * SEQ; const bf16* ff1 = FILT + (size_t)(2048 + c) * SEQ; const bf16* fb1 = FILT + (size_t)(3072 + c) * SEQ;
#pragma unroll
            for (int h = 0; h < 2; ++h) { int tq = tid; FFT_LAUNDER(tq); const int n0 = (tq + NTHR * h) * 8;
                const v4u wf0 = *(const v4u*)(ff0 + n0), wb0 = *(const v4u*)(fb0 + n0), wf1 = *(const v4u*)(ff1 + n0), wb1 = *(const v4u*)(fb1 + n0);
                const float vf0[8] = {bflo(wf0.x), bfhi(wf0.x), bflo(wf0.y), bfhi(wf0.y), bflo(wf0.z), bfhi(wf0.z), bflo(wf0.w), bfhi(wf0.w)};
                const float vb0[8] = {bflo(wb0.x), bfhi(wb0.x), bflo(wb0.y), bfhi(wb0.y), bflo(wb0.z), bfhi(wb0.z), bflo(wb0.w), bfhi(wb0.w)};
                const float vf1[8] = {bflo(wf1.x), bfhi(wf1.x), bflo(wf1.y), bfhi(wf1.y), bflo(wf1.z), bfhi(wf1.z), bflo(wf1.w), bfhi(wf1.w)};
                const float vb1[8] = {bflo(wb1.x), bfhi(wb1.x), bflo(wb1.y), bfhi(wb1.y), bflo(wb1.z), bfhi(wb1.z), bflo(wb1.w), bfhi(wb1.w)};
#pragma unroll
                for (int e = 0; e < 8; ++e) { const int n = n0 + e; const float dc = __expf(nd * (float)n); x[fswz(n)] = (f32x2){vf0[e] * dc, vf1[e] * dc};
                    if (n > 0) x[fswz(16384 - n)] = (f32x2){vb0[e] * dc, vb1[e] * dc}; } }
            if (tid == 0) x[8192] = (f32x2){0.f, 0.f};
            __syncthreads();
            if (tid == 0) { x[0].x += hb[c]; x[0].y += hb[HYW + c]; }
            __syncthreads();
            fft_fwd(x, T0, T1, tid);
#pragma unroll
            for (int i = 0; i < 32; ++i) { int tq = tid; FFT_LAUNDER(tq); const int p = tq + NTHR * i, pp = fft_partner_slot(p);
                const f32x2 u = x[p], w = x[pp];
                kf[i] = (f32x2){u.x + w.x, u.y - w.y} * (0.5f / 16384.0f);
                Zs[p] = __builtin_bit_cast(unsigned long long, u); }
            asm volatile("s_waitcnt vmcnt(0)" ::: "memory");
            __syncthreads();
        }
#pragma unroll
        for (int o = 0; o < 2; ++o) {
            if (o == 0) {
                const float w0 = cw[c], w1 = cw[3072 + c], w2 = cw[6144 + c], cb = cbv[c];
                const bf16* r0 = HYT + (size_t)c * MTOK; const bf16* r1 = r0 + SEQ;
#pragma unroll
                for (int h = 0; h < 2; ++h) { int tq = tid; FFT_LAUNDER(tq); const int n0 = (tq + NTHR * h) * 8; float u0[8], u1[8];
                    conv8(r0, n0, w0, w1, w2, cb, u0); conv8(r1, n0, w0, w1, w2, cb, u1);
#pragma unroll
                    for (int e = 0; e < 8; ++e) { x[fswz(n0 + e)] = (f32x2){u0[e], u1[e]}; x[fswz(8192 + n0 + e)] = (f32x2){0.f, 0.f}; } }
            } else {
#pragma unroll
                for (int i = 0; i < 32; ++i) { int tq = tid; FFT_LAUNDER(tq); const int p = tq + NTHR * i, pp = fft_partner_slot(p);
                    const f32x2 u = __builtin_bit_cast(f32x2, __hip_atomic_load(Zs + p, __ATOMIC_RELAXED, __HIP_MEMORY_SCOPE_AGENT));
                    const f32x2 w = __builtin_bit_cast(f32x2, __hip_atomic_load(Zs + pp, __ATOMIC_RELAXED, __HIP_MEMORY_SCOPE_AGENT));
                    kf[i] = (f32x2){u.y + w.y, w.x - u.x} * (0.5f / 16384.0f); }
#pragma unroll
                for (int h = 0; h < 2; ++h) { int tq = tid; FFT_LAUNDER(tq); const int n0 = (tq + NTHR * h) * 8;
#pragma unroll
                    for (int e = 0; e < 8; ++e) { x[fswz(n0 + e)] = zr[h * 8 + e]; x[fswz(8192 + n0 + e)] = (f32x2){0.f, 0.f}; } }
            }
            __syncthreads();
            fft_fwd(x, T0, T1, tid);
#pragma unroll
            for (int i = 0; i < 32; ++i) x[tid + NTHR * i] = cmul(x[tid + NTHR * i], kf[i]);
            __syncthreads();
            fft_inv(x, T0, T1, tid);
            if (o == 0) {
                const float w0 = cw[1024 + c], w1 = cw[3072 + 1024 + c], w2 = cw[6144 + 1024 + c], cb = cbv[1024 + c];
                const bf16* r0 = HYT + (size_t)(1024 + c) * MTOK; const bf16* r1 = r0 + SEQ;
#pragma unroll
                for (int h = 0; h < 2; ++h) { int tq = tid; FFT_LAUNDER(tq); const int n0 = (tq + NTHR * h) * 8; float g0[8], g1[8];
                    conv8(r0, n0, w0, w1, w2, cb, g0); conv8(r1, n0, w0, w1, w2, cb, g1);
#pragma unroll
                    for (int e = 0; e < 8; ++e) { const f32x2 r = x[fswz(n0 + e)]; zr[h * 8 + e] = (f32x2){g0[e] * r.x, g1[e] * r.y}; } }
                __syncthreads();
            }
        }
        {
            const float w0 = cw[2048 + c], w1 = cw[3072 + 2048 + c], w2 = cw[6144 + 2048 + c], cb = cbv[2048 + c];
            const bf16* r0 = HYT + (size_t)(2048 + c) * MTOK; const bf16* r1 = r0 + SEQ;
#pragma unroll
            for (int h = 0; h < 2; ++h) { int tq = tid; FFT_LAUNDER(tq); const int n0 = (tq + NTHR * h) * 8; float g0[8], g1[8];
                conv8(r0, n0, w0, w1, w2, cb, g0); conv8(r1, n0, w0, w1, w2, cb, g1);
                float y0[8], y1[8];
#pragma unroll
                for (int e = 0; e < 8; ++e) { const f32x2 r = x[fswz(n0 + e)]; y0[e] = g0[e] * r.x; y1[e] = g1[e] * r.y; }
                *(v4u*)(YT + (size_t)c * SEQ + n0) = (v4u){pk2(y0[0], y0[1]), pk2(y0[2], y0[3]), pk2(y0[4], y0[5]), pk2(y0[6], y0[7])};
                *(v4u*)(YT + (size_t)(HYW + c) * SEQ + n0) = (v4u){pk2(y1[0], y1[1]), pk2(y1[2], y1[3]), pk2(y1[4], y1[5]), pk2(y1[6], y1[7])}; }
            __syncthreads();
        }
    }
}

__device__ __forceinline__ void combine_phase(LAS unsigned char* lds, int wave) {
    LANE_TID;
    unsigned char* ws = KWS;
    const int gw = blockIdx.x * NWAVES + wave, NGW = gridDim.x * NWAVES;
    const float lam = __expf(wave_sum(((const float*)KARG(20))[lane] * ((const float*)KARG(21))[lane])) - __expf(wave_sum(((const float*)KARG(22))[lane] * ((const float*)KARG(23))[lane])) + 0.2f;
    const bf16* OC = (const bf16*)(ws + WS_OC); bf16* YA = (bf16*)(ws + WS_YATT);
    const float* sg = (const float*)KARG(24);
    const int h = lane >> 3, sub = lane & 7;
    float g[16];
#pragma unroll
    for (int i = 0; i < 16; ++i) g[i] = sg[sub * 16 + i] * 0.8f;
    for (int tok = gw; tok < MTOK; tok += NGW) {
        const bf16* p1 = OC + (size_t)tok * 2048 + (2 * h) * 128 + sub * 16; const bf16* p2 = p1 + 128;
        const v4u a0 = *(const v4u*)p1, a1 = *(const v4u*)(p1 + 8), b0 = *(const v4u*)p2, b1 = *(const v4u*)(p2 + 8);
        float d[16];
        const unsigned aw[8] = {a0.x, a0.y, a0.z, a0.w, a1.x, a1.y, a1.z, a1.w}, bw[8] = {b0.x, b0.y, b0.z, b0.w, b1.x, b1.y, b1.z, b1.w};
        float ss = 0.f;
#pragma unroll
        for (int i = 0; i < 8; ++i) { d[2 * i] = bflo(aw[i]) - lam * bflo(bw[i]); d[2 * i + 1] = bfhi(aw[i]) - lam * bfhi(bw[i]); ss += d[2 * i] * d[2 * i] + d[2 * i + 1] * d[2 * i + 1]; }
        ss += __shfl_xor(ss, 1); ss += __shfl_xor(ss, 2); ss += __shfl_xor(ss, 4);
        const float rinv = rsqrtf(ss * (1.0f / 128.0f) + 1e-6f);
        unsigned ow[8];
#pragma unroll
        for (int i = 0; i < 8; ++i) ow[i] = pk2(d[2 * i] * rinv * g[2 * i], d[2 * i + 1] * rinv * g[2 * i + 1]);
        bf16* op = YA + (size_t)tok * 1024 + h * 128 + sub * 16;
        *(v4u*)op = (v4u){ow[0], ow[1], ow[2], ow[3]}; *(v4u*)(op + 8) = (v4u){ow[4], ow[5], ow[6], ow[7]};
    }
    {
        const bf16* YT = (const bf16*)(ws + WS_YHYT); bf16* YH = (bf16*)(ws + WS_YHY);
        LAS bf16* t = (LAS bf16*)(lds + wave * 9216);
        for (int it = gw; it < 16 * 256; it += NGW) {
            const int cb = it & 15, tb = it >> 4;
            const int bidx = tb >> 7, n0 = (tb & 127) * 64;
#pragma unroll
            for (int r = 0; r < 8; ++r) { const int ch = r * 8 + (lane >> 3), tk = (lane & 7) * 8;
                const v4u w = *(const v4u*)(YT + ((size_t)(bidx * HYW + cb * 64 + ch)) * SEQ + n0 + tk);
                const unsigned ww[4] = {w.x, w.y, w.z, w.w};
#pragma unroll
                for (int e = 0; e < 4; ++e) { t[(tk + 2 * e) * 72 + ch] = (bf16)(ww[e] & 0xffffu); t[(tk + 2 * e + 1) * 72 + ch] = (bf16)(ww[e] >> 16); } }
            asm volatile("s_waitcnt lgkmcnt(0)" ::: "memory");
#pragma unroll
            for (int r = 0; r < 8; ++r) { const int tk = r * 8 + (lane >> 3), ch = (lane & 7) * 8;
                const v4u w = *(const LAS v4u*)(t + tk * 72 + ch);
                *(v4u*)(YH + (size_t)(tb * 64 + tk) * 1024 + cb * 64 + ch) = w; }
            asm volatile("s_waitcnt lgkmcnt(0)" ::: "memory");
        }
    }
}


__device__ __forceinline__ void seam_barrier(unsigned* w, unsigned G, int wave) {
    asm volatile("s_waitcnt vmcnt(0)" ::: "memory");
    __syncthreads();
    if (wave == 0) {
        if (lane_id() == 0) {
            const unsigned g = blockIdx.x & 7u, nper = (G + 7u - g) >> 3, ng = G < 8u ? G : 8u;
            __builtin_amdgcn_fence(__ATOMIC_RELEASE, "agent");
            asm volatile("s_waitcnt vmcnt(0)" ::: "memory");
            const unsigned old = __hip_atomic_fetch_add(w + 64 * (1 + g), 1u, __ATOMIC_RELAXED, __HIP_MEMORY_SCOPE_AGENT);
            if (old == nper - 1u) {
                __hip_atomic_fetch_add(w, 1u, __ATOMIC_RELAXED, __HIP_MEMORY_SCOPE_AGENT);
                while (__hip_atomic_load(w, __ATOMIC_RELAXED, __HIP_MEMORY_SCOPE_AGENT) < ng) __builtin_amdgcn_s_sleep(1);
                __hip_atomic_store(w + 64 * (9 + g), 1u, __ATOMIC_RELAXED, __HIP_MEMORY_SCOPE_AGENT);
            } else {
                while (__hip_atomic_load(w + 64 * (9 + g), __ATOMIC_RELAXED, __HIP_MEMORY_SCOPE_AGENT) == 0u) __builtin_amdgcn_s_sleep(1);
            }
            __builtin_amdgcn_fence(__ATOMIC_ACQUIRE, "agent");
            asm volatile("s_waitcnt vmcnt(0)" ::: "memory");
        }
    }
    __syncthreads();
}

__global__ void __launch_bounds__(NTHR) mega_fwd(Args a) {
    extern __shared__ __attribute__((aligned(16))) unsigned char shm[];
    cg::grid_group grid = cg::this_grid();
    LAS unsigned char* lds = (LAS unsigned char*)shm;
    const int wave = __builtin_amdgcn_readfirstlane(threadIdx.x >> 6);

    const int G = gridDim.x;
#define ws (KWS)
#define lo (KARGI(272))
#define hi (KARGI(276))
#ifndef DUP_P0
#define DUP_P0 0
#endif
#ifndef DUP_HY
#define DUP_HY 0
#endif
#ifndef DUP_ATT
#define DUP_ATT 0
#endif
#ifndef PHMASK
#define PHMASK 0x3ff
#endif
#define IN(k) (((PHMASK >> (k)) & 1) && lo <= (k) && (k) < hi)
#define SEAM(k) do { if (IN(k) && IN((k) + 1)) seam_barrier((unsigned*)(ws + WS_BAR) + 2048 * (k), (unsigned)G, wave); } while (0)
#define modp ((const float*)(ws + WS_MODP))
#define mod ((float*)(ws + WS_MOD))
#define ACT ((bf16*)(ws + WS_ACT))

    if (KARGI(272) < 0) grid.sync();
    if (IN(0)) for (int rep_ = KARGI(280); rep_ > 0; --rep_) phase0(lds, wave);
    SEAM(0);
    if (IN(1)) {
        LANE_TID;
        LAS float* fac = (LAS float*)lds; LAS float* sh = fac + 2 * DM;
        const float* b_ada = (const float*)KARG(4); const float* g = (const float*)KARG(5);
        for (int i = tid; i < 2 * DM; i += NTHR) { const int b = i >> 11, col = i & 2047;
            fac[i] = g[col] * (1.0f + mod_from_partials(modp, b_ada, b, DM + col)); sh[i] = mod_from_partials(modp, b_ada, b, col); }
        for (int i = blockIdx.x * NTHR + tid; i < 2 * NMOD; i += G * NTHR) { const int b = i / NMOD, j = i % NMOD; mod[i] = mod_from_partials(modp, b_ada, b, j); }
        __syncthreads();
        norm_rows<2>((const float*)KARG(0), ACT, ws + WS_H8, fac, sh, blockIdx.x * NWAVES + wave, G * NWAVES, lane);
        __syncthreads();
        pg8::Gemm gm{(const bf16*)(ws + WS_WTF), (const bf16*)(ws + WS_H3), 4096, 8192, 128}; pg8::StaticOrder S; S.init(4096, 8192, G, (int)blockIdx.x);
        pg8::EpiPlain E{(bf16*)(ws + WS_FILT), SEQ};
        pg8::gemm_phase<pg8::EpiPlain, pg8::StaticOrder, true, true>(lds, gm, S, E, wave);
    }
    SEAM(1);
    if (IN(2)) {
        { pg8::Gemm gm{(const bf16*)(ws + WS_WTHY), ACT, 3072, MTOK, DM}; pg8::StaticOrder S; S.init(3072, MTOK, G, (int)blockIdx.x);
          pg8::EpiPlain E{(bf16*)(ws + WS_HYT), MTOK};
          pg8::gemm_phase<pg8::EpiPlain, pg8::StaticOrder, true, true>(lds, gm, S, E, wave); }
        { pg8::Gemm gm{ACT, (const bf16*)(ws + WS_WTRE), MTOK, 3072, DM}; pg8::StaticOrder S; S.init(MTOK, 3072, G, (int)blockIdx.x);
          pg8::EpiProj E{(bf16*)(ws + WS_Q), (bf16*)(ws + WS_K), (bf16*)(ws + WS_V), (bf16*)KOUT, (const float*)(ws + WS_ROPE), (const float*)KARG(18), (const float*)KARG(19), 0};
          pg8::gemm_phase<pg8::EpiProj, pg8::StaticOrder, true, true>(lds, gm, S, E, wave); }
        { pg8::Gemm gm{(const bf16*)(ws + WS_H8), (const bf16*)(ws + WS_WTG8), MTOK, 4096, DM / 2}; pg8::StaticOrder S; S.init(MTOK, 4096, G, (int)blockIdx.x);
          pg8::EpiProj E{(bf16*)(ws + WS_Q), (bf16*)(ws + WS_K), (bf16*)(ws + WS_V), (bf16*)KOUT, (const float*)(ws + WS_ROPE), (const float*)KARG(18), (const float*)KARG(19), 12};
          pg8::gemm_phase<pg8::EpiProj, pg8::StaticOrder, true, true, 1>(lds, gm, S, E, wave); }
    }
    SEAM(2);
    if (IN(3)) {
        for (int rep_ = KARGI(292); rep_ > 0; --rep_) { hyena_phase(lds, wave); __syncthreads(); }
        __syncthreads();
        float sh_att;
        { LANE_TID; float gq = fabsf(((const float*)KARG(18))[lane]), gk = fabsf(((const float*)KARG(19))[lane]);
#pragma unroll
          for (int o_ = 1; o_ < 64; o_ <<= 1) { gq = fmaxf(gq, __shfl_xor(gq, o_)); gk = fmaxf(gk, __shfl_xor(gk, o_)); }
          const float bound = 64.0f * gq * gk * (0.125f * 1.4426950408889634f) * 1.02f; sh_att = __uint_as_float(__builtin_amdgcn_readfirstlane(__float_as_uint((bound > 64.0f) ? bound : 0.f))); }
        const int vcu = (G % 8 == 0) ? ((int)blockIdx.x % 8) * (G / 8) + (int)blockIdx.x / 8 : (int)blockIdx.x;
        for (int rep_ = KARGI(296); rep_ > 0; --rep_)
        for (int u = vcu; u < 1024; u += G) {
            const int bh = u >> 5, qb = u & 31, b = bh >> 4, qh = bh & 15;
            const bf16* Qb = (const bf16*)(ws + WS_Q) + ((size_t)b * SEQ + qb * 256) * 1024 + qh * 64;
            const bf16* Kh = (const bf16*)(ws + WS_K) + ((size_t)b * SEQ) * 1024 + qh * 64;
            const bf16* Vh = (const bf16*)(ws + WS_V) + ((size_t)b * SEQ) * 1024 + (qh >> 1) * 128;
            bf16* Ob = (bf16*)(ws + WS_OC) + ((size_t)b * SEQ + qb * 256) * 2048 + qh * 128;
            att::attn_unit(Qb, Kh, Vh, Ob, (char*)shm, wave, sh_att, (rep_ >= 2) ? 0 : 1);
        }
    }
    SEAM(3);
#ifdef PROBE_SEAMS
    for (int k_ = 9; k_ < 16; ++k_) seam_barrier((unsigned*)(ws + WS_BAR) + 2048 * k_, (unsigned)G, wave);
#endif
    if (IN(4)) combine_phase(lds, wave);
    SEAM(4);
    if (IN(5)) {
        { pg8::Gemm gm{(const bf16*)(ws + WS_YHY), (const bf16*)(ws + WS_WTPH), MTOK, DM, HYW}; pg8::StaticOrder S; S.init(MTOK, DM, G, (int)blockIdx.x);
          pg8::EpiGate1 E{(bf16*)(ws + WS_T), (const bf16*)KOUT};
          pg8::gemm_phase<pg8::EpiGate1, pg8::StaticOrder, true, true>(lds, gm, S, E, wave); }
        { pg8::Gemm gm{(const bf16*)(ws + WS_YATT), (const bf16*)(ws + WS_WTPA), MTOK, DM, HYW}; pg8::StaticOrder S; S.init(MTOK, DM, G, (int)blockIdx.x);
          pg8::EpiGate2 E{(const bf16*)(ws + WS_T), (const bf16*)KOUT, ACT};
          pg8::gemm_phase<pg8::EpiGate2, pg8::StaticOrder, true, true>(lds, gm, S, E, wave); }
    }
    SEAM(5);
    if (IN(6)) {
        pg8::Gemm gm{ACT, (const bf16*)(ws + WS_WTO), MTOK, DM, DM}; pg8::StaticOrder S; S.init(MTOK, DM, G, (int)blockIdx.x);
        pg8::EpiRes E{(const float*)KARG(0), KOUT, mod + 2 * DM, NMOD};
        pg8::gemm_phase<pg8::EpiRes, pg8::StaticOrder, true, true>(lds, gm, S, E, wave);
    }
    SEAM(6);
    if (IN(7)) {
        LANE_TID;
        LAS float* fac = (LAS float*)lds; LAS float* sh = fac + 2 * DM;
        const float* g = (const float*)KARG(28);
        for (int i = tid; i < 2 * DM; i += NTHR) { const int b = i >> 11, col = i & 2047; fac[i] = g[col] * (1.0f + mod[b * NMOD + 4 * DM + col]); sh[i] = mod[b * NMOD + 3 * DM + col]; }
        __syncthreads();
        norm_rows<1>(KOUT, ACT, nullptr, fac, sh, blockIdx.x * NWAVES + wave, G * NWAVES, lane);
        __syncthreads();
    }
    SEAM(7);
    if (IN(8)) {
        pg8::Gemm gm{ACT, (const bf16*)(ws + WS_WTGU), MTOK, 2 * FFH, DM / 2};
        pg8::StaticOrder S; S.init(MTOK, 2 * FFH, G, (int)blockIdx.x);
        pg8::EpiSwiGLU E{ws + WS_F};
        pg8::gemm_phase<pg8::EpiSwiGLU, pg8::StaticOrder, true, true, 1>(lds, gm, S, E, wave);
    }
    SEAM(8);
    if (IN(9)) {
        pg8::Gemm gm{(const bf16*)(ws + WS_F), (const bf16*)(ws + WS_WTDN), MTOK, DM, FFH / 2};
        pg8::StaticOrder S; S.init(MTOK, DM, G, (int)blockIdx.x);
        pg8::EpiRes E{KOUT, KOUT, mod + 5 * DM, NMOD};
        pg8::gemm_phase<pg8::EpiRes, pg8::StaticOrder, true, true, 1>(lds, gm, S, E, wave);
    }
#undef IN
#undef SEAM
#undef ws
#undef lo
#undef hi
#undef modp
#undef mod
#undef ACT
}

#ifndef MK_CUTS
#define MK_CUTS 0
#endif
extern "C" void kernel_launch(void* const* d_in, const int* in_sizes, int n_in, void* d_out, int out_size, void* d_ws, size_t ws_size, hipStream_t stream) {
    static int grid = 0;
    if (grid == 0) {
        if (n_in != 32 || in_sizes[0] != MTOK * DM || out_size != MTOK * DM || ws_size < WS_END) {
            fprintf(stderr, "kernel_launch: unexpected shapes: n_in %d in0 %d out %d ws %zu (need >= %zu)\n", n_in, n_in > 0 ? in_sizes[0] : -1, out_size, ws_size, (size_t)WS_END); grid = -1; return; }
        int dev = 0, cus = 0, per_cu = 0;
        hipGetDevice(&dev); hipDeviceGetAttribute(&cus, hipDeviceAttributeMultiprocessorCount, dev);
        if (hipFuncSetAttribute((const void*)mega_fwd, hipFuncAttributeMaxDynamicSharedMemorySize, LDS_BYTES) != hipSuccess) { fprintf(stderr, "kernel_launch: hipFuncSetAttribute failed\n"); grid = -1; return; }
        if (hipOccupancyMaxActiveBlocksPerMultiprocessor(&per_cu, (const void*)mega_fwd, NTHR, LDS_BYTES) != hipSuccess || per_cu < 1) { fprintf(stderr, "kernel_launch: occupancy query says %d blocks per CU\n", per_cu); per_cu = 1; }
        (void)hipGetLastError();
        grid = cus;
        if (grid % 8 != 0 || grid <= 0) { fprintf(stderr, "kernel_launch: odd CU count %d\n", grid); }
    }
    if (grid < 0) return;
    if (hipMemsetAsync((char*)d_ws + WS_BAR, 0, 131072, stream) != hipSuccess) { fprintf(stderr, "kernel_launch: hipMemsetAsync of the barrier words failed\n"); return; }
    Args a{};
    for (int i = 0; i < 32; ++i) a.in[i] = d_in[i];
    a.out = (float*)d_out; a.ws = (unsigned char*)d_ws;
    for (int i = 0; i < 12; ++i) a.rep[i] = 1;
#ifdef PROBE_REP
    a.rep[PROBE_REP] = 2;
#endif
#if MK_CUTS
    for (int p = 0; p < 10; ++p) { a.ph_lo = p; a.ph_hi = p + 1; void* args[] = {&a};
        hipError_t e = hipLaunchCooperativeKernel((const void*)mega_fwd, dim3(grid), dim3(NTHR), args, LDS_BYTES, stream);
        if (e != hipSuccess) { fprintf(stderr, "kernel_launch: cooperative launch failed: %s\n", hipGetErrorString(e)); break; } }
#else
    a.ph_lo = 0; a.ph_hi = 10; void* args[] = {&a};
    hipError_t e = hipLaunchCooperativeKernel((const void*)mega_fwd, dim3(grid), dim3(NTHR), args, LDS_BYTES, stream);
    if (e != hipSuccess) fprintf(stderr, "kernel_launch: cooperative launch failed: %s (grid %d)\n", hipGetErrorString(e), grid);
#endif
}
```
